# Optimizing an MI355X kernel written in HIP

```python
import jax, jax.numpy as jnp
from jax import lax
import numpy as np

D_MODEL = 1024
BATCH = 8
SEQ = 2048
DEPTH = 4

CHUNK = 64
N_MIXERS = 2
N_ATTN_LAYERS = (DEPTH + 1) // 2
N_REC_LAYERS = DEPTH // 2

N_HEADS = 16
HEAD_DIM = D_MODEL // N_HEADS
LEFT_CHUNKS = 8
BAND_CHUNKS = LEFT_CHUNKS + 1
BAND = BAND_CHUNKS * CHUNK
MAX_REL_DIST = 128
N_REL = 2 * MAX_REL_DIST + 1
NEG_INF = -1e30

D_RNN = D_MODEL
N_RG_BLOCKS = 8
RG_BLOCK = D_RNN // N_RG_BLOCKS
CONV_WIDTH = 4
RG_C = 8.0

D_FF = 4 * D_MODEL
RMS_EPS = 1e-6

kernel_name = "hybrid_chunk_attn_rglru_trunk"


def rmsnorm(x, g):
    xf = x.astype(jnp.float32)
    y = xf * lax.rsqrt(jnp.mean(xf * xf, axis=-1, keepdims=True) + RMS_EPS)
    return (y * g.astype(jnp.float32)).astype(x.dtype)


def chunked_band_attention(h, w_qkv, w_o, rel_table):
    B, S, _ = h.shape
    n_chunks = S // CHUNK
    qkv = jnp.einsum('bsd,de->bse', h, w_qkv).reshape(B, S, 3, N_HEADS, HEAD_DIM)
    q, k, v = qkv[:, :, 0], qkv[:, :, 1], qkv[:, :, 2]
    pad = LEFT_CHUNKS * CHUNK
    k_pad = jnp.pad(k, ((0, 0), (pad, 0), (0, 0), (0, 0)))
    v_pad = jnp.pad(v, ((0, 0), (pad, 0), (0, 0), (0, 0)))
    q_chunks = q.reshape(B, n_chunks, CHUNK, N_HEADS, HEAD_DIM).transpose(1, 0, 2, 3, 4)
    qi = jnp.arange(CHUNK)[:, None]
    kj = jnp.arange(BAND)[None, :]
    rel = qi + pad - kj
    idx = jnp.clip(rel, -MAX_REL_DIST, MAX_REL_DIST) + MAX_REL_DIST
    bias = rel_table[:, idx].astype(jnp.float32)
    scale = HEAD_DIM ** -0.5
    band_offsets = jnp.arange(BAND)

    def one_chunk(args):
        c, q_c = args
        start = c * CHUNK
        k_band = lax.dynamic_slice_in_dim(k_pad, start, BAND, axis=1)
        v_band = lax.dynamic_slice_in_dim(v_pad, start, BAND, axis=1)
        s = jnp.einsum('bqhd,bkhd->bhqk', q_c, k_band).astype(jnp.float32) * scale + bias
        key_pos = start - pad + band_offsets
        s = jnp.where(key_pos[None, None, None, :] >= 0, s, NEG_INF)
        p = jax.nn.softmax(s, axis=-1).astype(v_band.dtype)
        return jnp.einsum('bhqk,bkhd->bqhd', p, v_band)

    o = lax.map(one_chunk, (jnp.arange(n_chunks), q_chunks))
    o = o.transpose(1, 0, 2, 3, 4).reshape(B, S, D_MODEL)
    return jnp.einsum('bsd,de->bse', o, w_o)


def rglru_block(h, w_in, b_in, conv_w, conv_b, w_ga, b_ga, w_gx, b_gx, a_param, w_o, b_o):
    B, S, _ = h.shape
    u = jnp.einsum('bsd,de->bse', h, w_in) + b_in
    x_br = u[..., :D_RNN]
    y_br = jax.nn.gelu(u[..., D_RNN:], approximate=True)
    xp = jnp.pad(x_br, ((0, 0), (CONV_WIDTH - 1, 0), (0, 0)))
    xc = conv_b + xp[:, 0:S] * conv_w[0]
    for tap in range(1, CONV_WIDTH):
        xc = xc + xp[:, tap:tap + S] * conv_w[tap]
    xb = xc.reshape(B, S, N_RG_BLOCKS, RG_BLOCK)
    r = jax.nn.sigmoid(jnp.einsum('bsnc,nce->bsne', xb, w_ga) + b_ga).reshape(B, S, D_RNN)
    ig = jax.nn.sigmoid(jnp.einsum('bsnc,nce->bsne', xb, w_gx) + b_gx).reshape(B, S, D_RNN)
    log_a = -RG_C * r.astype(jnp.float32) * jax.nn.softplus(-a_param.astype(jnp.float32))
    a = jnp.exp(log_a)
    mult = jnp.sqrt(-jnp.expm1(2.0 * log_a))
    b_seq = mult * (ig * xc).astype(jnp.float32)

    def combine(left, right):
        a1, b1 = left
        a2, b2 = right
        return a1 * a2, a2 * b1 + b2

    _, hs = lax.associative_scan(combine, (a, b_seq), axis=1)
    out = hs.astype(h.dtype) * y_br
    return jnp.einsum('bse,ed->bsd', out, w_o) + b_o


def sq_relu_mlp(h, w1, w2):
    z = jax.nn.relu(jnp.einsum('bsd,df->bsf', h, w1))
    return jnp.einsum('bsf,fd->bsd', z * z, w2)


def setup_inputs(seed: int = 0) -> dict:
    key = jax.random.key(seed)
    ks = jax.random.split(key, 20)
    nrm = lambda k, shape, s: jax.random.normal(k, shape, jnp.float32) * s
    x = jax.random.normal(ks[0], (BATCH, SEQ, D_MODEL), jnp.float32)
    norm_mix = 1.0 + nrm(ks[1], (DEPTH, D_MODEL), 0.05)
    norm_mlp = 1.0 + nrm(ks[2], (DEPTH, D_MODEL), 0.05)
    attn_w_qkv = nrm(ks[3], (N_ATTN_LAYERS, D_MODEL, 3 * D_MODEL), D_MODEL ** -0.5)
    attn_w_o = nrm(ks[4], (N_ATTN_LAYERS, D_MODEL, D_MODEL), D_MODEL ** -0.5)
    attn_rel_bias = nrm(ks[5], (N_ATTN_LAYERS, N_HEADS, N_REL), 0.2)
    rec_w_in = nrm(ks[6], (N_REC_LAYERS, D_MODEL, 2 * D_RNN), D_MODEL ** -0.5)
    rec_b_in = nrm(ks[7], (N_REC_LAYERS, 2 * D_RNN), 0.02)
    rec_conv_w = nrm(ks[8], (N_REC_LAYERS, CONV_WIDTH, D_RNN), CONV_WIDTH ** -0.5)
    rec_conv_b = nrm(ks[9], (N_REC_LAYERS, D_RNN), 0.02)
    rec_w_ga = nrm(ks[10], (N_REC_LAYERS, N_RG_BLOCKS, RG_BLOCK, RG_BLOCK), RG_BLOCK ** -0.5)
    rec_b_ga = nrm(ks[11], (N_REC_LAYERS, N_RG_BLOCKS, RG_BLOCK), 0.02)
    rec_w_gx = nrm(ks[12], (N_REC_LAYERS, N_RG_BLOCKS, RG_BLOCK, RG_BLOCK), RG_BLOCK ** -0.5)
    rec_b_gx = nrm(ks[13], (N_REC_LAYERS, N_RG_BLOCKS, RG_BLOCK), 0.02)
    a0 = jax.random.uniform(ks[14], (N_REC_LAYERS, D_RNN), jnp.float32, 0.81, 0.998)
    s0 = a0 ** (1.0 / RG_C)
    rec_a_param = jnp.log(s0) - jnp.log1p(-s0)
    rec_w_o = nrm(ks[15], (N_REC_LAYERS, D_RNN, D_MODEL), D_RNN ** -0.5)
    rec_b_o = nrm(ks[16], (N_REC_LAYERS, D_MODEL), 0.02)
    mlp_w1 = nrm(ks[17], (DEPTH, D_MODEL, D_FF), D_MODEL ** -0.5)
    mlp_w2 = nrm(ks[18], (DEPTH, D_FF, D_MODEL), D_FF ** -0.5)
    norm_final = 1.0 + nrm(ks[19], (D_MODEL,), 0.05)
    return {"x": x, "norm_mix": norm_mix, "norm_mlp": norm_mlp,
            "attn_w_qkv": attn_w_qkv, "attn_w_o": attn_w_o, "attn_rel_bias": attn_rel_bias,
            "rec_w_in": rec_w_in, "rec_b_in": rec_b_in, "rec_conv_w": rec_conv_w,
            "rec_conv_b": rec_conv_b, "rec_w_ga": rec_w_ga, "rec_b_ga": rec_b_ga,
            "rec_w_gx": rec_w_gx, "rec_b_gx": rec_b_gx, "rec_a_param": rec_a_param,
            "rec_w_o": rec_w_o, "rec_b_o": rec_b_o,
            "mlp_w1": mlp_w1, "mlp_w2": mlp_w2, "norm_final": norm_final}


def reference(x, norm_mix, norm_mlp, attn_w_qkv, attn_w_o, attn_rel_bias,
              rec_w_in, rec_b_in, rec_conv_w, rec_conv_b, rec_w_ga, rec_b_ga,
              rec_w_gx, rec_b_gx, rec_a_param, rec_w_o, rec_b_o,
              mlp_w1, mlp_w2, norm_final):
    h = x
    for layer in range(DEPTH):
        hn = rmsnorm(h, norm_mix[layer])
        j = layer // N_MIXERS
        if layer % N_MIXERS == 0:
            mix = chunked_band_attention(hn, attn_w_qkv[j], attn_w_o[j], attn_rel_bias[j])
        else:
            mix = rglru_block(hn, rec_w_in[j], rec_b_in[j], rec_conv_w[j], rec_conv_b[j],
                              rec_w_ga[j], rec_b_ga[j], rec_w_gx[j], rec_b_gx[j],
                              rec_a_param[j], rec_w_o[j], rec_b_o[j])
        h = h + mix
        h = h + sq_relu_mlp(rmsnorm(h, norm_mlp[layer]), mlp_w1[layer], mlp_w2[layer])
    return rmsnorm(h, norm_final)
```

```cpp
#include <hip/hip_runtime.h>
#include <hip/hip_bf16.h>
#include <cstdio>
#include <cstdint>
#include <math.h>
#ifndef FAST_SUBS
#define FAST_SUBS 8
#endif
namespace pg8 {
#define PG8_LAS __attribute__((address_space(3)))
typedef unsigned short bf16_t;
typedef short bf16x8 __attribute__((ext_vector_type(8)));
typedef float f32x4 __attribute__((ext_vector_type(4)));
typedef float f32x2 __attribute__((ext_vector_type(2)));
typedef unsigned u32x4 __attribute__((ext_vector_type(4)));
typedef unsigned u32x2 __attribute__((ext_vector_type(2)));
constexpr int BM = 256, BK = 64, HALF = 128, HTB = HALF * BK * 2  , STAGE_BYTES = 8 * HTB, NXCD = 8, WGM = 8;
constexpr int TOK = 16384, DMODEL = 1024, SEQL = 2048;
constexpr size_t PANEL_BYTES = 2752512;
constexpr int PO_Z = 0, PO_Q = 0, PO_K = 512 * 1024, PO_V = 1024 * 1024, PO_O = 1536 * 1024, PO_Y = 0, PO_AL = 512 * 1024, PO_BQ = 1024 * 1024, PO_G = 1536 * 1024, PO_X = 2048 * 1024;
static_assert((size_t)PO_X + 259 * 2048 <= PANEL_BYTES, "panel map");
constexpr int KT = 256 * 64, KTX = 259 * 64;

constexpr float RMS_EPS = 1e-6f;
constexpr float C2 = 0.125f * 1.4426950408889634f;

__host__ __device__ __forceinline__ int lds_byte(int r, int c) { const int st = (r >> 4) * 2 + (c >> 5), rr = r & 15, cc = c & 31, ob = rr * 64 + cc * 2; return st * 1024 + (ob ^ (((ob >> 9) & 1) << 5)); }
__host__ __device__ __forceinline__ void stage_rc(int b, int& R, int& C) { const int st = b / 1024, sb = b % 1024, swz = sb ^ (((sb >> 9) & 1) << 5); R = (st >> 1) * 16 + swz / 64; C = (st & 1) * 32 + (swz % 64) / 2; }
__host__ __device__ __forceinline__ int perm32(int rho) { const int n = rho >> 4, i = rho & 15; return 8 * (i >> 2) + 4 * n + (i & 3); }

struct Unit { int pm, pn; };
struct Gemm { const char* A; size_t apstride; const bf16_t* Bt; int K; int lda; int kts; };
template <int MODE> __device__ __forceinline__ const char* a_base(const Gemm& g, const Unit& u) {
    if (MODE == 0) return g.A + (size_t)u.pm * g.apstride;
    return g.A + (size_t)u.pm * g.apstride + (size_t)(2 * u.pn) * (KTX * 2);
}
template <int MODE> __device__ __forceinline__ size_t koff(const Gemm& g, int t) {
    if (MODE == 0) return (size_t)t * (size_t)g.kts;
    return (size_t)(t & 1) * (KTX * 2) + (size_t)(t >> 1) * 128;
}

struct StaticOrder {
    int nM, nN, nwg, G, c;
    __host__ __device__ void init(int M, int N, int G_, int c_) { nM = M / BM; nN = N / BM; nwg = nM * nN; G = G_; c = c_; }
    __host__ __device__ bool next(int i, Unit& u) const {
        const long L = (long)i * G + c; if (L >= nwg) return false;
        int wgid = (int)L; { const int q = nwg / NXCD, r = nwg % NXCD, xcd = wgid % NXCD, off = wgid / NXCD; wgid = (xcd < r ? xcd * (q + 1) : r * (q + 1) + (xcd - r) * q) + off; }
        const int nig = WGM * nN, gid = wgid / nig, fm = gid * WGM, gsz = (nM - fm) < WGM ? (nM - fm) : WGM;
        u.pm = fm + ((wgid % nig) % gsz); u.pn = (wgid % nig) / gsz; return true;
    }
};

__device__ __forceinline__ unsigned cvt_pk_bf16(float lo, float hi) { unsigned r; asm volatile("v_cvt_pk_bf16_f32 %0, %1, %2" : "=v"(r) : "v"(lo), "v"(hi)); return r; }
__device__ __forceinline__ void st16(bf16_t* p, u32x4 v) { *(u32x4*)p = v; }
__device__ __forceinline__ float quarter_sum(float s) {
    s += __int_as_float(__builtin_amdgcn_ds_swizzle(__float_as_int(s), 0x401F));
    const auto rr = __builtin_amdgcn_permlane32_swap(__float_as_uint(s), __float_as_uint(s), false, false);
    return __uint_as_float(rr[0]) + __uint_as_float(rr[1]);
}
__device__ __forceinline__ int tid_of(int wave) { unsigned m = ~0u; asm volatile("" : "+s"(m));
    return wave * 64 + (int)__builtin_amdgcn_mbcnt_hi(m, __builtin_amdgcn_mbcnt_lo(m, 0u)); }
__device__ __forceinline__ float bf_lo(unsigned u) { return __uint_as_float(u << 16); }
__device__ __forceinline__ float bf_hi(unsigned u) { return __uint_as_float(u & 0xffff0000u); }
constexpr int RSTD_LDS_OFF = 131072 + 2048;
__device__ __forceinline__ float rstd_of(const float* ssq, int row) {
    const float s = (ssq[row] + ssq[TOK + row]) + (ssq[2 * TOK + row] + ssq[3 * TOK + row]);
    return __builtin_amdgcn_rsqf(s * (1.0f / DMODEL) + RMS_EPS);
}


struct EpiQKV {
    static constexpr bool PERM = true, AFTER_DRAIN = false, NEED_RSTD = true;
    unsigned char* big; const float* ssq;
    __device__ __forceinline__ void operator()(const f32x4 (&acc)[2][2][4][2], const Unit& u, int wr, int wc, int fr, int fq, const PG8_LAS float* rstdL) const {
        const int t = u.pn >> 2; bf16_t* base = (bf16_t*)(big + (size_t)u.pm * PANEL_BYTES + PO_Q + (size_t)t * (PO_K - PO_Q)); const float sc0 = t == 0 ? C2 : 1.f;
        const int rl0 = wr * 64 + fr; const size_t co = (size_t)(4 * (u.pn & 3) + (wc >> 1)) * KT + 32 * (wc & 1) + 8 * fq;
#pragma unroll
        for (int ai = 0; ai < 2; ++ai)
#pragma unroll
            for (int m = 0; m < 4; ++m) { const int rl = rl0 + ai * HALF + m * 16; const float sc = rstdL[rl] * sc0; bf16_t* rowp = base + co + (size_t)rl * 64;
#pragma unroll
                for (int bj = 0; bj < 2; ++bj) { const f32x4 v0 = acc[ai][bj][m][0] * sc, v1 = acc[ai][bj][m][1] * sc;
                    u32x4 w; w.x = cvt_pk_bf16(v0[0], v0[1]); w.y = cvt_pk_bf16(v0[2], v0[3]); w.z = cvt_pk_bf16(v1[0], v1[1]); w.w = cvt_pk_bf16(v1[2], v1[3]);
                    *(u32x4*)(rowp + (size_t)bj * (2 * KT)) = w; } }
    }
};
struct EpiUp {
    static constexpr bool PERM = true, AFTER_DRAIN = false, NEED_RSTD = true;
    unsigned char* big; const float* ssq;
    __device__ __forceinline__ void operator()(const f32x4 (&acc)[2][2][4][2], const Unit& u, int wr, int wc, int fr, int fq, const PG8_LAS float* rstdL) const {
        bf16_t* base = (bf16_t*)(big + (size_t)u.pm * PANEL_BYTES + PO_Z);
        const int rl0 = wr * 64 + fr; const size_t co = (size_t)(4 * u.pn + (wc >> 1)) * 16384 + 32 * (wc & 1) + 8 * fq;
#pragma unroll
        for (int ai = 0; ai < 2; ++ai)
#pragma unroll
            for (int m = 0; m < 4; ++m) { const int rl = rl0 + ai * HALF + m * 16; const float sc = rstdL[rl]; bf16_t* rowp = base + co + (size_t)rl * 64;
#pragma unroll
                for (int bj = 0; bj < 2; ++bj) { f32x4 v0 = acc[ai][bj][m][0] * sc, v1 = acc[ai][bj][m][1] * sc;
#pragma unroll
                    for (int i = 0; i < 4; ++i) { v0[i] = fmaxf(v0[i], 0.f); v1[i] = fmaxf(v1[i], 0.f); }
                    v0 = v0 * v0; v1 = v1 * v1;
                    u32x4 w; w.x = cvt_pk_bf16(v0[0], v0[1]); w.y = cvt_pk_bf16(v0[2], v0[3]); w.z = cvt_pk_bf16(v1[0], v1[1]); w.w = cvt_pk_bf16(v1[2], v1[3]);
                    st16(rowp + (size_t)bj * 32768, w); } }
    }
};
__device__ __forceinline__ float gelu_tanh(float v) {
    const float z = v * (1.0f + 0.044715f * v * v) * (-2.0f * 0.7978845608028654f * 1.4426950408889634f);
    return v * __builtin_amdgcn_rcpf(1.0f + __builtin_amdgcn_exp2f(z));
}
struct EpiIn {
    static constexpr bool PERM = true, AFTER_DRAIN = false, NEED_RSTD = true;
    unsigned char* big; const float* ssq; const float* bias;
    __device__ __forceinline__ void operator()(const f32x4 (&acc)[2][2][4][2], const Unit& u, int wr, int wc, int fr, int fq, const PG8_LAS float* rstdL) const {
        const bool isy = u.pn >= 4, has_nxt = (u.pm & 7) != 7;
        unsigned char* pan = big + (size_t)u.pm * PANEL_BYTES;
        const int rl0 = wr * 64 + fr, ktl = 4 * (u.pn & 3) + (wc >> 1), cl = 32 * (wc & 1) + 8 * fq, bcol0 = u.pn * BM + wc * 32 + 8 * fq;
        f32x4 bv[2][2];
#pragma unroll
        for (int bj = 0; bj < 2; ++bj)
#pragma unroll
            for (int n = 0; n < 2; ++n) bv[bj][n] = *(const f32x4*)(bias + bcol0 + bj * HALF + 4 * n);
#pragma unroll
        for (int ai = 0; ai < 2; ++ai)
#pragma unroll
            for (int m = 0; m < 4; ++m) { const int rl = rl0 + ai * HALF + m * 16; const float sc = rstdL[rl];
                const size_t kst = isy ? (size_t)KT : (size_t)KTX;
                bf16_t* rowp = isy ? ((bf16_t*)(pan + PO_Y) + (size_t)ktl * KT + (size_t)rl * 64 + cl) : ((bf16_t*)(pan + PO_X) + (size_t)ktl * KTX + (size_t)(rl + 3) * 64 + cl);
                const bool halo = !isy && has_nxt && rl >= BM - 3;
                bf16_t* hrow = (bf16_t*)(pan + PANEL_BYTES + PO_X) + (size_t)ktl * KTX + (size_t)(rl - (BM - 3)) * 64 + cl;
#pragma unroll
                for (int bj = 0; bj < 2; ++bj) { f32x4 v0 = acc[ai][bj][m][0] * sc + bv[bj][0], v1 = acc[ai][bj][m][1] * sc + bv[bj][1];
                    if (isy) {
#pragma unroll
                        for (int i = 0; i < 4; ++i) { v0[i] = gelu_tanh(v0[i]); v1[i] = gelu_tanh(v1[i]); } }
                    u32x4 w; w.x = cvt_pk_bf16(v0[0], v0[1]); w.y = cvt_pk_bf16(v0[2], v0[3]); w.z = cvt_pk_bf16(v1[0], v1[1]); w.w = cvt_pk_bf16(v1[2], v1[3]);
                    *(u32x4*)(rowp + (size_t)bj * 2 * kst) = w;
                    if (halo) *(u32x4*)(hrow + (size_t)bj * 2 * KTX) = w; } }
    }
};
struct EpiGate {
    static constexpr bool PERM = true, AFTER_DRAIN = false, NEED_RSTD = false;
    unsigned char* big; const float* gc;
    __device__ __forceinline__ void operator()(const f32x4 (&acc)[2][2][4][2], const Unit& u, int wr, int wc, int fr, int fq, const PG8_LAS float*) const {
        const int rl0 = wr * 64 + fr, ch0 = u.pn * 128 + wc * 32 + 8 * fq;
        bf16_t* AL = (bf16_t*)(big + (size_t)u.pm * PANEL_BYTES + PO_AL); bf16_t* BQ = (bf16_t*)(big + (size_t)u.pm * PANEL_BYTES + PO_BQ);
        float ba[8], bx[8], c8[8];
#pragma unroll
        for (int i = 0; i < 8; ++i) { const f32x4 c = *(const f32x4*)(gc + (size_t)(ch0 + i) * 8); ba[i] = c[0]; bx[i] = c[1]; c8[i] = c[3]; }
#pragma unroll
        for (int ai = 0; ai < 2; ++ai)
#pragma unroll
            for (int m = 0; m < 4; ++m) { const int row = rl0 + ai * HALF + m * 16;
                float la2[8], bq[8];
#pragma unroll
                for (int i = 0; i < 8; ++i) { const float ga = acc[ai][0][m][i >> 2][i & 3], gx = acc[ai][1][m][i >> 2][i & 3];
                    const float r = __builtin_amdgcn_rcpf(1.0f + __builtin_amdgcn_exp2f(-(ga + ba[i]) * 1.4426950408889634f));
                    const float ig = __builtin_amdgcn_rcpf(1.0f + __builtin_amdgcn_exp2f(-(gx + bx[i]) * 1.4426950408889634f));
                    la2[i] = c8[i] * r;
                    const float om = 1.0f - __builtin_amdgcn_exp2f(2.0f * la2[i]);
                    bq[i] = __builtin_amdgcn_sqrtf(om) * ig; }
                u32x4 wa, wb;
                wa.x = cvt_pk_bf16(la2[0], la2[1]); wa.y = cvt_pk_bf16(la2[2], la2[3]); wa.z = cvt_pk_bf16(la2[4], la2[5]); wa.w = cvt_pk_bf16(la2[6], la2[7]);
                wb.x = cvt_pk_bf16(bq[0], bq[1]); wb.y = cvt_pk_bf16(bq[2], bq[3]); wb.z = cvt_pk_bf16(bq[4], bq[5]); wb.w = cvt_pk_bf16(bq[6], bq[7]);
                const size_t eo = (size_t)(2 * u.pn + (wc >> 1)) * KT + (size_t)row * 64 + 32 * (wc & 1) + 8 * fq;
                *(u32x4*)(AL + eo) = wa; *(u32x4*)(BQ + eo) = wb;
            }
    }
};
struct EpiRes {
    static constexpr bool PERM = true, AFTER_DRAIN = true, NEED_RSTD = false;
    bf16_t* hb; float* ssq; const float* bias;
    __device__ __forceinline__ void fused(f32x4 (&acc)[2][2][4][2], const Unit& u, int wr, int wc, int fr, int fq, PG8_LAS unsigned char* lds, int wid, int lane) const {
        PG8_LAS float* P = (PG8_LAS float*)lds;
        const int col0 = u.pn * BM + wc * 32 + 8 * fq;
        bf16_t* hbp = hb + (size_t)u.pm * (BM * DMODEL) + (size_t)(4 * u.pn + (wc >> 1)) * KT + 32 * (wc & 1) + 8 * fq;
        f32x4 bv[2][2];
#pragma unroll
        for (int bj = 0; bj < 2; ++bj)
#pragma unroll
            for (int n = 0; n < 2; ++n) bv[bj][n] = bias ? *(const f32x4*)(bias + col0 + bj * HALF + 4 * n) : (f32x4){0.f, 0.f, 0.f, 0.f};
#pragma unroll
        for (int ai = 0; ai < 2; ++ai) {
            u32x4 rr[4][2];
#pragma unroll
            for (int m = 0; m < 4; ++m)
#pragma unroll
                for (int bj = 0; bj < 2; ++bj) rr[m][bj] = *(const u32x4*)(hbp + (size_t)(ai * HALF + wr * 64 + m * 16 + fr) * 64 + (size_t)bj * (2 * KT));
#pragma unroll
            for (int m = 0; m < 4; ++m) { const int rl = ai * HALF + wr * 64 + m * 16 + fr;
                float s = 0.f;
#pragma unroll
                for (int bj = 0; bj < 2; ++bj) { const u32x4 r = rr[m][bj];
                    const f32x4 r0 = (f32x4){bf_lo(r.x), bf_hi(r.x), bf_lo(r.y), bf_hi(r.y)}, r1 = (f32x4){bf_lo(r.z), bf_hi(r.z), bf_lo(r.w), bf_hi(r.w)};
                    const f32x4 v0 = acc[ai][bj][m][0] + bv[bj][0] + r0, v1 = acc[ai][bj][m][1] + bv[bj][1] + r1;
                    s += (v0[0] * v0[0] + v0[1] * v0[1]) + (v0[2] * v0[2] + v0[3] * v0[3]) + (v1[0] * v1[0] + v1[1] * v1[1]) + (v1[2] * v1[2] + v1[3] * v1[3]);
                    u32x4 w; w.x = cvt_pk_bf16(v0[0], v0[1]); w.y = cvt_pk_bf16(v0[2], v0[3]); w.z = cvt_pk_bf16(v1[0], v1[1]); w.w = cvt_pk_bf16(v1[2], v1[3]);
                    *(u32x4*)(hbp + (size_t)rl * 64 + (size_t)bj * (2 * KT)) = w;
                }
                s = quarter_sum(s);
                if (fq == 0) P[wc * 256 + rl] = s;
            }
            asm volatile("" ::: "memory");
        }
        asm volatile("s_waitcnt lgkmcnt(0)" ::: "memory"); __builtin_amdgcn_s_barrier(); asm volatile("" ::: "memory");
        const int tid = wid * 64 + lane;
        if (tid < 256) { const float s = (P[tid] + P[256 + tid]) + (P[512 + tid] + P[768 + tid]); ssq[(size_t)u.pn * TOK + u.pm * BM + tid] = s; }
    }
};

template <class Epi, int MODE, bool ALIGN_EPI = false, bool SP2 = false>
__device__ __forceinline__ void gemm_phase(PG8_LAS unsigned char* lds, const Gemm g, const StaticOrder& S, const Epi& E, int wave) {
    int tid_ = tid_of(wave); asm volatile("" : "+v"(tid_));
    const int tid = tid_, wid = __builtin_amdgcn_readfirstlane(tid >> 6), lane = tid & 63, wr = wid >> 2, wc = wid & 3, fr = lane & 15, fq = lane >> 4;
    const int K = g.K, nt = K / BK, lda = g.lda;
    unsigned voffA[2], voffB[2];
#pragma unroll
    for (int i = 0; i < 2; ++i) { int R, C; stage_rc(tid * 16 + i * 8192, R, C); const int Rb = Epi::PERM ? ((R & ~31) + perm32(R & 31)) : R;
        voffA[i] = (unsigned)(R * lda + C) * 2u; voffB[i] = (unsigned)(Rb * K + C) * 2u; }
    const size_t kstep = (size_t)(BK * 2);
    const size_t hstepA = (size_t)HALF * lda * 2, hstepB = (size_t)HALF * K * 2;
    const unsigned ldsw = (unsigned)wid * 1024u;
    const int aoff = lds_byte(wr * 64 + fr, fq * 8), boff = lds_byte(wc * 32 + fr, fq * 8);
#define PG8_SA(b, h) (((b) * 2 + (h)) * HTB)
#define PG8_SB(b, h) ((4 + (b) * 2 + (h)) * HTB)
#define PG8_STAGE(bufoff, gbase, voff) do { _Pragma("unroll") for (int _i = 0; _i < 2; ++_i) \
        __builtin_amdgcn_global_load_lds((const unsigned*)((const char*)(gbase) + (voff)[_i]), (PG8_LAS unsigned*)(lds + (bufoff) + ldsw + _i * 8192), 16, 0, 0); } while (0)
#define PG8_LDA(dst, b, h) do { _Pragma("unroll") for (int m = 0; m < 4; ++m) _Pragma("unroll") for (int k = 0; k < 2; ++k) dst[m][k] = *(const PG8_LAS bf16x8*)(lds + PG8_SA(b, h) + aoff + m * 2048 + k * 1024); } while (0)
#define PG8_LDB(dst, b, h) do { _Pragma("unroll") for (int n = 0; n < 2; ++n) _Pragma("unroll") for (int k = 0; k < 2; ++k) dst[n][k] = *(const PG8_LAS bf16x8*)(lds + PG8_SB(b, h) + boff + n * 2048 + k * 1024); } while (0)
#define PG8_MMA(ai, bj, At, Bt) do { __builtin_amdgcn_s_setprio(1); _Pragma("unroll") for (int m = 0; m < 4; ++m) _Pragma("unroll") for (int n = 0; n < 2; ++n) _Pragma("unroll") for (int k = 0; k < 2; ++k) \
        acc[ai][bj][m][n] = __builtin_amdgcn_mfma_f32_16x16x32_bf16(Bt[n][k], At[m][k], acc[ai][bj][m][n], 0, 0, 0); __builtin_amdgcn_s_setprio(0); } while (0)
#define PG8_WAIT_V(n) asm volatile("s_waitcnt vmcnt(" #n ")" ::: "memory")
#define PG8_WAIT_L(n) asm volatile("s_waitcnt lgkmcnt(" #n ")" ::: "memory")
#define PG8_BAR __builtin_amdgcn_s_barrier()
#define PG8_SCHED __builtin_amdgcn_sched_barrier(0)
    Unit cur, nxt; int ui = 0;
    if (!S.next(0, cur)) return;
    f32x4 acc[2][2][4][2];
#pragma unroll
    for (int a = 0; a < 2; ++a)
#pragma unroll
        for (int b = 0; b < 2; ++b)
#pragma unroll
            for (int m = 0; m < 4; ++m)
#pragma unroll
                for (int n = 0; n < 2; ++n) acc[a][b][m][n] = (f32x4){0.f, 0.f, 0.f, 0.f};
    bf16x8 At[4][2], B0[2][2], B1[2][2];
    const char* cA = a_base<MODE>(g, cur); const char* cB = (const char*)g.Bt + (size_t)cur.pn * 2 * hstepB;
    const size_t ko1 = koff<MODE>(g, 1);
    const PG8_LAS float* rstdL = (const PG8_LAS float*)(lds + RSTD_LDS_OFF);
    float my_rstd = 0.f;
    if constexpr (Epi::NEED_RSTD) { if (tid < BM) my_rstd = rstd_of(E.ssq, cur.pm * BM + tid); }
    if constexpr (SP2) {
        PG8_STAGE(PG8_SB(0, 0), cB, voffB); PG8_STAGE(PG8_SB(0, 1), cB + hstepB, voffB); PG8_STAGE(PG8_SA(0, 0), cA, voffA); PG8_STAGE(PG8_SA(0, 1), cA + hstepA, voffA);
        if (wr == 1) PG8_BAR;
        PG8_WAIT_V(2); PG8_BAR;
        PG8_STAGE(PG8_SB(1, 0), cB + kstep, voffB); PG8_STAGE(PG8_SA(1, 0), cA + ko1, voffA); PG8_STAGE(PG8_SB(1, 1), cB + hstepB + kstep, voffB);
        PG8_WAIT_V(6); PG8_BAR;
    } else {
        PG8_STAGE(PG8_SB(0, 0), cB, voffB); PG8_STAGE(PG8_SA(0, 0), cA, voffA); PG8_STAGE(PG8_SB(0, 1), cB + hstepB, voffB); PG8_STAGE(PG8_SA(0, 1), cA + hstepA, voffA);
        if (wr == 1) PG8_BAR;
        PG8_WAIT_V(4); PG8_BAR;
        PG8_STAGE(PG8_SB(1, 0), cB + kstep, voffB); PG8_STAGE(PG8_SA(1, 0), cA + ko1, voffA); PG8_STAGE(PG8_SB(1, 1), cB + hstepB + kstep, voffB);
        PG8_WAIT_V(6); PG8_BAR;
    }
    if constexpr (Epi::NEED_RSTD) { if (tid < BM) ((PG8_LAS float*)(lds + RSTD_LDS_OFF))[tid] = my_rstd; }
    for (;;) {
        const bool has_next = S.next(ui + 1, nxt);
        const char* nA = has_next ? a_base<MODE>(g, nxt) : cA; const char* nB = has_next ? (const char*)g.Bt + (size_t)nxt.pn * 2 * hstepB : cB;
        for (int t = 0; t < nt; t += 2) {
            const bool last = (t == nt - 2);
            const char* a1 = cA + koff<MODE>(g, t + 1);
            const char* a2 = last ? nA : cA + koff<MODE>(g, t + 2); const char* b2 = last ? nB : cB + (size_t)(t + 2) * kstep;
            const char* a3 = last ? nA + ko1 : cA + koff<MODE>(g, t + 3); const char* b3 = b2 + kstep;
            if constexpr (SP2) {
            PG8_LDB(B0, 0, 0); PG8_LDB(B1, 0, 1); PG8_SCHED; PG8_LDA(At, 0, 0); PG8_STAGE(PG8_SA(1, 1), a1 + hstepA, voffA);
            PG8_WAIT_V(8); PG8_WAIT_L(0); PG8_BAR; PG8_MMA(0, 0, At, B0); PG8_MMA(0, 1, At, B1); PG8_BAR; PG8_SCHED;
            PG8_LDA(At, 0, 1); PG8_STAGE(PG8_SB(0, 0), b2, voffB); PG8_STAGE(PG8_SB(0, 1), b2 + hstepB, voffB); PG8_STAGE(PG8_SA(0, 0), a2, voffA);
            PG8_WAIT_V(8); PG8_WAIT_L(0); PG8_BAR; PG8_MMA(1, 0, At, B0); PG8_MMA(1, 1, At, B1); PG8_BAR; PG8_SCHED;
            PG8_LDB(B0, 1, 0); PG8_LDB(B1, 1, 1); PG8_SCHED; PG8_LDA(At, 1, 0); PG8_STAGE(PG8_SA(0, 1), a2 + hstepA, voffA);
            PG8_WAIT_V(8); PG8_WAIT_L(0); PG8_BAR; PG8_MMA(0, 0, At, B0); PG8_MMA(0, 1, At, B1); PG8_BAR; PG8_SCHED;
            PG8_LDA(At, 1, 1); PG8_STAGE(PG8_SB(1, 0), b3, voffB); PG8_STAGE(PG8_SB(1, 1), b3 + hstepB, voffB); PG8_STAGE(PG8_SA(1, 0), a3, voffA);
            PG8_WAIT_V(8); PG8_WAIT_L(0); PG8_BAR; PG8_MMA(1, 0, At, B0); PG8_MMA(1, 1, At, B1); PG8_BAR; PG8_SCHED;
            } else {
            PG8_LDB(B0, 0, 0); PG8_SCHED; PG8_LDA(At, 0, 0); PG8_STAGE(PG8_SA(1, 1), a1 + hstepA, voffA);
            PG8_WAIT_L(8); PG8_BAR; PG8_WAIT_L(0); PG8_MMA(0, 0, At, B0); PG8_BAR; PG8_SCHED;
            PG8_LDB(B1, 0, 1); PG8_STAGE(PG8_SB(0, 0), b2, voffB);
            PG8_BAR; PG8_WAIT_L(0); PG8_MMA(0, 1, At, B1); PG8_BAR;
            PG8_LDA(At, 0, 1); PG8_STAGE(PG8_SA(0, 0), a2, voffA);
            PG8_BAR; PG8_WAIT_L(0); PG8_MMA(1, 0, At, B0); PG8_BAR; PG8_SCHED;
            PG8_STAGE(PG8_SB(0, 1), b2 + hstepB, voffB);
            PG8_WAIT_V(6); PG8_BAR; PG8_MMA(1, 1, At, B1); PG8_BAR;
            PG8_LDB(B0, 1, 0); PG8_SCHED; PG8_LDA(At, 1, 0); PG8_STAGE(PG8_SA(0, 1), a2 + hstepA, voffA);
            PG8_WAIT_L(8); PG8_BAR; PG8_WAIT_L(0); PG8_MMA(0, 0, At, B0); PG8_BAR; PG8_SCHED;
            PG8_LDB(B1, 1, 1); PG8_STAGE(PG8_SB(1, 0), b3, voffB);
            PG8_BAR; PG8_WAIT_L(0); PG8_MMA(0, 1, At, B1); PG8_BAR;
            PG8_LDA(At, 1, 1); PG8_STAGE(PG8_SA(1, 0), a3, voffA);
            PG8_BAR; PG8_WAIT_L(0); PG8_MMA(1, 0, At, B0); PG8_BAR; PG8_SCHED;
            PG8_STAGE(PG8_SB(1, 1), b3 + hstepB, voffB);
            PG8_WAIT_V(6); PG8_BAR; PG8_MMA(1, 1, At, B1); PG8_BAR;
            }
        }
        if constexpr (ALIGN_EPI) { if (wr == 0) PG8_BAR; }
        if constexpr (!Epi::AFTER_DRAIN) { E(acc, cur, wr, wc, fr, fq, rstdL); }
        if (!has_next) break;
#pragma unroll
        for (int a = 0; a < 2; ++a)
#pragma unroll
            for (int b = 0; b < 2; ++b)
#pragma unroll
                for (int m = 0; m < 4; ++m)
#pragma unroll
                    for (int n = 0; n < 2; ++n) acc[a][b][m][n] = (f32x4){0.f, 0.f, 0.f, 0.f};
        cur = nxt; cA = nA; cB = nB; ++ui;
        if constexpr (ALIGN_EPI) { if (wr == 1) PG8_BAR; }
    }
    PG8_WAIT_V(0);
    if constexpr (!ALIGN_EPI) { if (wr == 0) PG8_BAR; }
    PG8_BAR;
    if constexpr (Epi::AFTER_DRAIN) { E.fused(acc, cur, wr, wc, fr, fq, lds, wid, lane);
    }
#undef PG8_SA
#undef PG8_SB
#undef PG8_STAGE
#undef PG8_LDA
#undef PG8_LDB
#undef PG8_MMA
#undef PG8_WAIT_V
#undef PG8_WAIT_L
#undef PG8_BAR
#undef PG8_SCHED
}
}
namespace att {
using bf16x8 = __attribute__((ext_vector_type(8))) short;
using s16x4 = __attribute__((ext_vector_type(4))) short;
using f32x16 = __attribute__((ext_vector_type(16))) float;
using f32x4 = __attribute__((ext_vector_type(4))) float;
using u32x4 = __attribute__((ext_vector_type(4))) unsigned;
typedef unsigned short bf16_t;
#define ATT_LAS __attribute__((address_space(3)))
constexpr int DM = 1024, SEQ = 2048, D = 64, NW = 8, QBLK = 32, QB = 256, KVBLK = 64;
constexpr int NSLOT = 3, SLOTB = 8192;
constexpr int L_K = 0, L_V = NSLOT * SLOTB, L_WS = 2 * NSLOT * SLOTB, L_OST = L_WS + NW * 256, L_TAB = L_OST + NW * 4096, L_QN = L_TAB + 4 * 324 * 4 + 64  , L_END = L_QN + NW * 4096;
constexpr int TABN = 320;
constexpr int TABR = 324;
constexpr float THR = 8.0f;
__device__ __forceinline__ int crow(int r, int hi) { return (r & 3) + 8 * (r >> 2) + 4 * hi; }
#define ASBAR() __builtin_amdgcn_sched_barrier(0)
__device__ __forceinline__ void glds16(const void* gsrc, unsigned lds_dst) { unsigned keep;
    asm volatile("s_mov_b32 %0, m0\n\ts_mov_b32 m0, %2\n\ts_nop 0\n\tglobal_load_lds_dwordx4 %1, off\n\ts_mov_b32 m0, %0" : "=&s"(keep) : "v"(gsrc), "s"(lds_dst) : "memory"); }
__device__ __forceinline__ unsigned cvtpk(float lo, float hi) { unsigned r; asm volatile("v_cvt_pk_bf16_f32 %0, %1, %2" : "=v"(r) : "v"(lo), "v"(hi)); return r; }
#define ATT_WAIT_BAR(N) asm volatile("s_waitcnt vmcnt(" #N ") lgkmcnt(0)\n\ts_barrier" ::: "memory")

__device__ __forceinline__ void vread16(s16x4* lo, s16x4* hi, int vb) {
#pragma unroll
    for (int d0 = 0; d0 < 2; ++d0)
#pragma unroll
        for (int ks = 0; ks < 4; ++ks) {
            asm volatile("ds_read_b64_tr_b16 %0,%1 offset:%c2" : "=&v"(lo[4 * d0 + ks]) : "v"(vb), "i"(d0 * 4096 + ks * 1024) : "memory");
            asm volatile("ds_read_b64_tr_b16 %0,%1 offset:%c2" : "=&v"(hi[4 * d0 + ks]) : "v"(vb), "i"(d0 * 4096 + ks * 1024 + 512) : "memory"); }
}
__device__ __forceinline__ void pv16(f32x16* o, const s16x4* lo, const s16x4* hi, bf16x8 pa0, bf16x8 pa1, bf16x8 pa2, bf16x8 pa3) {
#define ATT_PK(k) (bf16x8){lo[k][0], lo[k][1], lo[k][2], lo[k][3], hi[k][0], hi[k][1], hi[k][2], hi[k][3]}
    o[0] = __builtin_amdgcn_mfma_f32_32x32x16_bf16(pa0, ATT_PK(0), o[0], 0, 0, 0); o[1] = __builtin_amdgcn_mfma_f32_32x32x16_bf16(pa0, ATT_PK(4), o[1], 0, 0, 0);
    o[0] = __builtin_amdgcn_mfma_f32_32x32x16_bf16(pa1, ATT_PK(1), o[0], 0, 0, 0); o[1] = __builtin_amdgcn_mfma_f32_32x32x16_bf16(pa1, ATT_PK(5), o[1], 0, 0, 0);
    o[0] = __builtin_amdgcn_mfma_f32_32x32x16_bf16(pa2, ATT_PK(2), o[0], 0, 0, 0); o[1] = __builtin_amdgcn_mfma_f32_32x32x16_bf16(pa2, ATT_PK(6), o[1], 0, 0, 0);
    o[0] = __builtin_amdgcn_mfma_f32_32x32x16_bf16(pa3, ATT_PK(3), o[0], 0, 0, 0); o[1] = __builtin_amdgcn_mfma_f32_32x32x16_bf16(pa3, ATT_PK(7), o[1], 0, 0, 0);
#undef ATT_PK
}
__device__ __forceinline__ float rowmax32(const f32x16& p0, const f32x16& p1) {
    float a = fmaxf(p0[0], p1[0]);
#pragma unroll
    for (int r = 1; r < 16; ++r) a = fmaxf(a, fmaxf(p0[r], p1[r]));
    auto rr = __builtin_amdgcn_permlane32_swap(__float_as_uint(a), __float_as_uint(a), false, false);
    return fmaxf(__uint_as_float(rr[0]), __uint_as_float(rr[1]));
}

__device__ __forceinline__ void attn_table(const float* tab, ATT_LAS unsigned char* shm, int wave) {
    const int tid = pg8::tid_of(wave); ATT_LAS float* tabL = (ATT_LAS float*)(shm + L_TAB);
    for (int idx = tid; idx < 4 * TABR; idx += NW * 64) { const int s_ = idx / TABR, k_ = idx % TABR - s_; tabL[idx] = (k_ >= 0 && k_ < TABN) ? tab[TABN - 1 - k_] : 0.f; }
}
__device__ __forceinline__ void attn_stream(int b, int h, int qb0, unsigned char* big, const float* tab, ATT_LAS unsigned char* shm, int wave) {
    int tid_ = pg8::tid_of(wave); asm volatile("" : "+v"(tid_));
    const int tid = tid_, lane = tid & 63, r32 = lane & 31, hi = lane >> 5; const int wid = __builtin_amdgcn_readfirstlane(tid >> 6);
    const int ci = wid >> 1;
    ATT_LAS float* tabL = (ATT_LAS float*)(shm + L_TAB);
    ATT_LAS float* wsf = (ATT_LAS float*)(shm + L_WS) + wid * 64;
    const long koffl = (long)h * pg8::KT + (long)lane * D + wid * 8, voffl = (long)h * pg8::KT + (long)(16 * (wid & 3) + (lane >> 2)) * D + (wid >> 2) * 32 + (lane & 3) * 8;
    const unsigned lds0 = (unsigned)(uintptr_t)shm;
    const unsigned kdst = lds0 + L_K + wid * 1024, vdst = lds0 + L_V + wid * 1024;
#define ATT_DMA_C(c_, slotoff) do { const unsigned char* pan_ = big + (size_t)(b * 8 + ((c_) >> 2)) * pg8::PANEL_BYTES; const long ro_ = (long)(((c_) & 3) * KVBLK) * D; \
        glds16((const bf16_t*)(pan_ + pg8::PO_K) + ro_ + koffl, (unsigned)__builtin_amdgcn_readfirstlane(kdst + (slotoff))); \
        glds16((const bf16_t*)(pan_ + pg8::PO_V) + ro_ + voffl, (unsigned)__builtin_amdgcn_readfirstlane(vdst + (slotoff))); } while (0)
#define ATT_CS(qb_) ((4 * (qb_) - 8) > 0 ? (4 * (qb_) - 8) : 0)
#define ATT_LOADQ(qb_) do { const bf16_t* qp_ = (const bf16_t*)(big + (size_t)(b * 8 + (qb_)) * pg8::PANEL_BYTES + pg8::PO_Q) + (long)h * pg8::KT + (long)(wid * QBLK) * D + lane * 8; \
        _Pragma("unroll") for (int i_ = 0; i_ < 4; ++i_) glds16(qp_ + i_ * 512, (unsigned)__builtin_amdgcn_readfirstlane(lds0 + L_QN + wid * 4096 + i_ * 1024)); } while (0)
    const int vb0 = (int)(lds0 + L_V) + ((lane >> 4) & 1) * 32 + (lane & 3) * 8 + (4 * hi + ((lane & 15) >> 2)) * 64;
    const int qi = (wid & 1) * 32 + r32;
    const int sj = (qi + 1) & 3, jb = 191 - qi + 4 * hi + sj;
    const float cfar = tab[TABN - 1];
    int Gtot = 0;
#pragma unroll
    for (int u = 0; u < 4; ++u) { const int qb_ = qb0 + 2 * u; Gtot += 4 * qb_ + 4 - ATT_CS(qb_); }
    bf16x8 qr[4];
#pragma unroll
    for (int d0 = 0; d0 < 4; ++d0) qr[d0] = bf16x8{};
    ATT_LOADQ(qb0);
    int dqb = qb0, dt = 0, dnt = 4 * qb0 + 4 - ATT_CS(qb0);
#define ATT_DMA_NEXT(slotoff) do { ATT_DMA_C(ATT_CS(dqb) + dt, slotoff); if (++dt == dnt) { dqb += 2; dt = 0; dnt = 4 * dqb + 4 - ATT_CS(dqb); } } while (0)
    ATT_DMA_NEXT(0); ATT_DMA_NEXT(SLOTB);
    int qb = qb0, t = 0, cs = ATT_CS(qb0), NT = 4 * qb0 + 4 - cs, cq = 4 * qb + ci, t_lo = ((cq - 8) > 0 ? (cq - 8) : 0) - cs, t_hi = cq - cs;
    float mhat = 0.f, l_reg = 0.f; f32x16 o[2]; o[0] = f32x16{}; o[1] = f32x16{};
    bool need_q = false, qwait = false;
    int slot = 0;
    for (int g = 0; g < Gtot; ++g) {
        if (g + 1 < Gtot) { if (qwait) { ATT_WAIT_BAR(6); } else { ATT_WAIT_BAR(2); } } else { ATT_WAIT_BAR(0); }
        qwait = false;
        if (g + 2 < Gtot) { const int s2 = (slot >= SLOTB) ? slot - SLOTB : slot + 2 * SLOTB; ATT_DMA_NEXT(s2); }
        if (need_q) { need_q = false; qwait = true; ATT_LOADQ(qb + ((t > t_hi) ? 2 : 0)); }
        if (t >= t_lo && t <= t_hi) {
            const int dc = t_hi - t;
            s16x4 vlo[8], vhi[8];
            vread16(vlo, vhi, vb0 + slot);
            bf16x8 kf[8];
            { const ATT_LAS unsigned char* kb = shm + L_K + slot + hi * 1024 + r32 * 16;
#pragma unroll
              for (int d0 = 0; d0 < 4; ++d0) { kf[2 * d0] = *reinterpret_cast<const ATT_LAS bf16x8*>(kb + d0 * 2048); kf[2 * d0 + 1] = *reinterpret_cast<const ATT_LAS bf16x8*>(kb + d0 * 2048 + 512); } }
            if (t == t_lo) { mhat = 0.f; l_reg = 0.f; o[0] = f32x16{}; o[1] = f32x16{};
                const ATT_LAS unsigned char* qn = shm + L_QN + wid * 4096 + r32 * 128 + hi * 16;
#pragma unroll
                for (int d0 = 0; d0 < 4; ++d0) qr[d0] = *reinterpret_cast<const ATT_LAS bf16x8*>(qn + d0 * 32); }
            f32x16 p0, p1;
            if (dc >= 3) {
                asm volatile("s_waitcnt lgkmcnt(0)" ::: "memory"); ASBAR();
#pragma unroll
                for (int r = 0; r < 16; ++r) { p0[r] = cfar - mhat; p1[r] = cfar - mhat; }
#pragma unroll
                for (int d0 = 0; d0 < 4; ++d0) { p0 = __builtin_amdgcn_mfma_f32_32x32x16_bf16(kf[2 * d0], qr[d0], p0, 0, 0, 0); p1 = __builtin_amdgcn_mfma_f32_32x32x16_bf16(kf[2 * d0 + 1], qr[d0], p1, 0, 0, 0); }
            } else {
                const ATT_LAS float* tb = tabL + sj * TABR + (jb - 64 * dc);
                f32x4 b0[4], b1[4];
#pragma unroll
                for (int g4 = 0; g4 < 4; ++g4) { b0[g4] = *(const ATT_LAS f32x4*)(tb + 8 * g4); b1[g4] = *(const ATT_LAS f32x4*)(tb + 32 + 8 * g4); }
                asm volatile("s_waitcnt lgkmcnt(0)" ::: "memory"); ASBAR();
#pragma unroll
                for (int r = 0; r < 16; ++r) { p0[r] = b0[r >> 2][r & 3] - mhat; p1[r] = b1[r >> 2][r & 3] - mhat; }
#pragma unroll
                for (int d0 = 0; d0 < 4; ++d0) { p0 = __builtin_amdgcn_mfma_f32_32x32x16_bf16(kf[2 * d0], qr[d0], p0, 0, 0, 0); p1 = __builtin_amdgcn_mfma_f32_32x32x16_bf16(kf[2 * d0 + 1], qr[d0], p1, 0, 0, 0); }
            }
            const float rm = rowmax32(p0, p1);
            if (t == t_lo) {
                mhat = rm;
#pragma unroll
                for (int r = 0; r < 16; ++r) { p0[r] -= rm; p1[r] -= rm; }
            } else if (__any(rm > THR)) {
                const float dl = fmaxf(rm, 0.f); mhat += dl;
#pragma unroll
                for (int r = 0; r < 16; ++r) { p0[r] -= dl; p1[r] -= dl; }
                const float f = __builtin_amdgcn_exp2f(-dl); l_reg *= f;
                if (hi == 0) wsf[r32] = f;
                asm volatile("s_waitcnt lgkmcnt(0)" ::: "memory");
#pragma unroll
                for (int g4 = 0; g4 < 4; ++g4) { const f32x4 fv = *(const ATT_LAS f32x4*)(wsf + 8 * g4 + 4 * hi);
#pragma unroll
                    for (int i = 0; i < 4; ++i) { o[0][4 * g4 + i] *= fv[i]; o[1][4 * g4 + i] *= fv[i]; } }
            }
            float sacc = 0.f;
#pragma unroll
            for (int r = 0; r < 16; ++r) { p0[r] = __builtin_amdgcn_exp2f(p0[r]); p1[r] = __builtin_amdgcn_exp2f(p1[r]); sacc += p0[r] + p1[r]; }
            l_reg += sacc;
            u32x4 pw0, pw1, pw2, pw3;
            pw0 = (u32x4){cvtpk(p0[0], p0[1]), cvtpk(p0[2], p0[3]), cvtpk(p0[4], p0[5]), cvtpk(p0[6], p0[7])};
            pw1 = (u32x4){cvtpk(p0[8], p0[9]), cvtpk(p0[10], p0[11]), cvtpk(p0[12], p0[13]), cvtpk(p0[14], p0[15])};
            pw2 = (u32x4){cvtpk(p1[0], p1[1]), cvtpk(p1[2], p1[3]), cvtpk(p1[4], p1[5]), cvtpk(p1[6], p1[7])};
            pw3 = (u32x4){cvtpk(p1[8], p1[9]), cvtpk(p1[10], p1[11]), cvtpk(p1[12], p1[13]), cvtpk(p1[14], p1[15])};
            ASBAR();
            pv16(o, vlo, vhi, __builtin_bit_cast(bf16x8, pw0), __builtin_bit_cast(bf16x8, pw1), __builtin_bit_cast(bf16x8, pw2), __builtin_bit_cast(bf16x8, pw3));
            if (t == t_hi) {
                { auto rr = __builtin_amdgcn_permlane32_swap(__float_as_uint(l_reg), __float_as_uint(l_reg), false, false); l_reg = __uint_as_float(rr[0]) + __uint_as_float(rr[1]); }
                if (hi == 0) wsf[32 + r32] = l_reg;
                asm volatile("s_waitcnt lgkmcnt(0)" ::: "memory");
                float rli[16];
#pragma unroll
                for (int g4 = 0; g4 < 4; ++g4) { const f32x4 lv = *(const ATT_LAS f32x4*)(wsf + 32 + 8 * g4 + 4 * hi);
#pragma unroll
                    for (int i = 0; i < 4; ++i) rli[4 * g4 + i] = __builtin_amdgcn_rcpf(lv[i]); }
                bf16_t* Ow = (bf16_t*)(big + (size_t)(b * 8 + qb) * pg8::PANEL_BYTES + pg8::PO_O) + (long)h * pg8::KT + (long)(wid * QBLK) * D;
                ATT_LAS bf16_t* stg = (ATT_LAS bf16_t*)(shm + L_OST) + wid * 2048;
#pragma unroll
                for (int r = 0; r < 16; ++r) { const int orow = crow(r, hi);
#pragma unroll
                    for (int d0 = 0; d0 < 2; ++d0) { const float v = o[d0][r] * rli[r]; const unsigned pk = cvtpk(v, v); stg[orow * 64 + d0 * 32 + r32] = (bf16_t)(pk & 0xffffu); } }
                asm volatile("s_waitcnt lgkmcnt(0)" ::: "memory");
#pragma unroll
                for (int i = 0; i < 4; ++i) { const int row = i * 8 + (lane >> 3), ch = lane & 7; const u32x4 v = *(const ATT_LAS u32x4*)(stg + row * 64 + ch * 8); *(u32x4*)(Ow + (long)row * D + ch * 8) = v; }
                need_q = (qb + 2 < qb0 + 8);
            }
        }
        slot = (slot == 2 * SLOTB) ? 0 : slot + SLOTB;
        if (++t == NT) { qb += 2; t = 0; cs = ATT_CS(qb); NT = 4 * qb + 4 - cs; cq = 4 * qb + ci; t_lo = ((cq - 8) > 0 ? (cq - 8) : 0) - cs; t_hi = cq - cs; }
    }
    asm volatile("s_waitcnt lgkmcnt(0)\n\ts_barrier" ::: "memory");
#undef ATT_DMA_C
#undef ATT_CS
#undef ATT_LOADQ
#undef ATT_DMA_NEXT
}
#undef ASBAR
}
constexpr int NWAVES = 8;
constexpr int BATCH = 8, SEQ = 2048, DM = 1024, NH = 16, FF = 4096, TOK = BATCH * SEQ, DEPTH = 4;
constexpr size_t MiB = 1u << 20;
constexpr size_t WS_CTL = 0, CTL_ZERO_BYTES = 1 * MiB;
constexpr size_t WS_TEXT = 1 * MiB;
constexpr size_t WS_GC = 1 * MiB + 64 * 1024;
constexpr size_t WS_SSQ = 1 * MiB + 256 * 1024;
constexpr size_t WS_ARENA = 2 * MiB, ARENA_BYTES = 24 * MiB;
constexpr size_t AR_MIX = 0, AR_WO = 6 * MiB, AR_WG = 4 * MiB, AR_W1 = 8 * MiB, AR_W2 = 16 * MiB;
constexpr size_t WS_HB = 50 * MiB;
constexpr size_t WS_BIG = 82 * MiB;
constexpr size_t WS_END = WS_BIG + 64 * pg8::PANEL_BYTES;
static_assert(WS_END <= 256 * MiB, "d_ws map");
constexpr int CW_BAR = 4096;

constexpr int RING_OFF = 0, RING_BYTES = 131072;
constexpr int LDSCTL_OFF = RING_BYTES, MISC_OFF = LDSCTL_OFF + 320;
constexpr int LDS_BYTES = 147456;
static_assert(att::L_END <= RING_BYTES, "attention scratch fits the ring region");

#define GAS __attribute__((address_space(1)))
#define LAS __attribute__((address_space(3)))
typedef unsigned short bf16;
typedef unsigned v4u __attribute__((ext_vector_type(4)));
typedef float f32x4 __attribute__((ext_vector_type(4)));
typedef GAS unsigned gu32;
#define RLX_AGENT __ATOMIC_RELAXED, __HIP_MEMORY_SCOPE_AGENT
#define LDS_WAIT() asm volatile("s_waitcnt lgkmcnt(0)" ::: "memory")
#define VM_WAIT() asm volatile("s_waitcnt vmcnt(0)" ::: "memory")
__device__ __forceinline__ unsigned f2bf(float f) { unsigned u = __builtin_bit_cast(unsigned, f); return (u + 0x7fffu + ((u >> 16) & 1u)) >> 16; }
__device__ __forceinline__ unsigned pk2(float lo, float hi) { return f2bf(lo) | (f2bf(hi) << 16); }

#define XB_TMO      128
#define XB_XCNT(j)  (256  + 64 * (j))
#define XB_XSUB(j)  (1280 + 64 * (j))
#define XB_XGEN(j)  (2304 + 64 * (j))
#define XB_TOP      3328
#define XB_TOPGEN   3392
#define XCD_BAR_WORDS 3456
#define XB_SPIN_CAP (1u << 18)
__device__ __forceinline__ unsigned xb_ld(unsigned* p)              { return __hip_atomic_load(p, __ATOMIC_RELAXED, __HIP_MEMORY_SCOPE_AGENT); }
__device__ __forceinline__ unsigned xb_add(unsigned* p, unsigned v) { return __hip_atomic_fetch_add(p, v, __ATOMIC_RELAXED, __HIP_MEMORY_SCOPE_AGENT); }
__device__ __forceinline__ unsigned xb_xcc_id() { return (unsigned)__builtin_amdgcn_s_getreg((3 << 11) | 20) & 0xFu; }
#define XB_SPIN(cond, bar) do { unsigned _sp = 0; while (cond) { __builtin_amdgcn_s_sleep(1); \
    if ((++_sp & 255u) == 0u) { if (xb_ld(&(bar)[XB_TMO])) break; if (_sp > XB_SPIN_CAP) { atomicAdd(&(bar)[XB_TMO], 1u); break; } } } } while (0)
struct XcdBarrier { unsigned* bar; unsigned x; volatile LAS unsigned* st; };
__device__ __forceinline__ XcdBarrier xcd_barrier_post(unsigned* bar, volatile LAS unsigned* st) {
    XcdBarrier b; b.bar = bar; b.x = xb_xcc_id(); b.st = st;
    if (threadIdx.x == 0) (void)xb_add(&bar[XB_XCNT(b.x)], 1u);
    return b;
}
__device__ __forceinline__ void xcd_barrier_complete(unsigned* bar, unsigned x, unsigned& nloc, unsigned& nx) {
    const unsigned G = gridDim.x * gridDim.y * gridDim.z;
    unsigned sum, cnt, mine, sp = 0u;
    for (;;) {
        sum = 0u; cnt = 0u; mine = 0u;
#pragma unroll
        for (unsigned j = 0; j < 16; ++j) { const unsigned c = xb_ld(&bar[XB_XCNT(j)]); sum += c; cnt += (c > 0u) ? 1u : 0u; mine = (j == x) ? c : mine; }
        if (sum == G) break;
        __builtin_amdgcn_s_sleep(1);
        if ((++sp & 255u) == 0u) { if (xb_ld(&bar[XB_TMO])) break; if (sp > XB_SPIN_CAP) { atomicAdd(&bar[XB_TMO], 1u); break; } }
    }
    nloc = mine > 0u ? mine : 1u; nx = cnt > 0u ? cnt : 1u;
}
__device__ __forceinline__ void xcd_barrier(const XcdBarrier& b, int wave) {
    asm volatile("s_waitcnt vmcnt(0)" ::: "memory");
    __syncthreads();
    if (pg8::tid_of(wave) == 0) {
        unsigned* bar = b.bar;
        __builtin_amdgcn_s_waitcnt(0);
        unsigned nloc = b.st[0], nx = b.st[1];
        if (nloc == 0u) { xcd_barrier_complete(bar, b.x, nloc, nx); b.st[0] = nloc; b.st[1] = nx; }
        const unsigned old = xb_add(&bar[XB_XSUB(b.x)], 1u);
        const unsigned gen = old / nloc;
        if (old + 1u == (gen + 1u) * nloc) {
            __builtin_amdgcn_fence(__ATOMIC_RELEASE, "agent");
            asm volatile("s_waitcnt vmcnt(0)" ::: "memory");
            const unsigned og = xb_add(&bar[XB_TOP], 1u);
            const unsigned tg = og / nx;
            if (og + 1u == (tg + 1u) * nx) xb_add(&bar[XB_TOPGEN], 1u);
            else XB_SPIN(xb_ld(&bar[XB_TOPGEN]) == tg, bar);
            __builtin_amdgcn_fence(__ATOMIC_ACQUIRE, "agent");
            xb_add(&bar[XB_XGEN(b.x)], 1u);
            asm volatile("s_waitcnt vmcnt(0)" ::: "memory");
        } else {
            XB_SPIN(xb_ld(&bar[XB_XGEN(b.x)]) == gen, bar);
            __builtin_amdgcn_fence(__ATOMIC_ACQUIRE, "agent");
            asm volatile("s_waitcnt vmcnt(0)" ::: "memory");
        }
    }
    __syncthreads();
}


#define GB_BASE(g)    (8192 + 1024 * (g))
#define GB_CEN(x)     (16 * (x))
#define GB_SUB(x)     (256 + 16 * (x))
#define GB_GEN(x)     (512 + 16 * (x))
#define GB_TOP        768
#define GB_TOPGEN     784
#define GB_SPIN(cond) do { unsigned _sp = 0; while (cond) { __builtin_amdgcn_s_sleep(1); if (++_sp > (1u << 22)) break; } } while (0)
__device__ __forceinline__ void group_barrier_post(unsigned* ctl, unsigned group) {
    if (threadIdx.x == 0) (void)xb_add(&ctl[GB_BASE(group) + GB_CEN(xb_xcc_id())], 1u);
}
__device__ __forceinline__ void group_barrier(unsigned* ctl, unsigned group, volatile LAS unsigned* st, int wave) {
    asm volatile("s_waitcnt vmcnt(0)" ::: "memory");
    __syncthreads();
    if (pg8::tid_of(wave) == 0) {
        unsigned* w = ctl + GB_BASE(group); const unsigned x = xb_xcc_id();
        __builtin_amdgcn_s_waitcnt(0);
        unsigned nloc = st[0], nx = st[1];
        if (nloc == 0u) { nx = 0u;
#pragma unroll
            for (unsigned j = 0; j < 16; ++j) { const unsigned c = xb_ld(&w[GB_CEN(j)]); nx += (c > 0u) ? 1u : 0u; nloc = (j == x) ? c : nloc; }
            nloc = nloc > 0u ? nloc : 1u; nx = nx > 0u ? nx : 1u; st[0] = nloc; st[1] = nx; }
        const unsigned old = xb_add(&w[GB_SUB(x)], 1u);
        const unsigned gen = old / nloc;
        if (old + 1u == (gen + 1u) * nloc) {
            if (nx > 1u) {
                __builtin_amdgcn_fence(__ATOMIC_RELEASE, "agent");
                asm volatile("s_waitcnt vmcnt(0)" ::: "memory");
                const unsigned og = xb_add(&w[GB_TOP], 1u);
                const unsigned tg = og / nx;
                if (og + 1u == (tg + 1u) * nx) xb_add(&w[GB_TOPGEN], 1u);
                else GB_SPIN(xb_ld(&w[GB_TOPGEN]) == tg);
            }
            __builtin_amdgcn_fence(__ATOMIC_ACQUIRE, "agent");
            xb_add(&w[GB_GEN(x)], 1u);
            asm volatile("s_waitcnt vmcnt(0)" ::: "memory");
        } else {
            GB_SPIN(xb_ld(&w[GB_GEN(x)]) == gen);
            __builtin_amdgcn_fence(__ATOMIC_ACQUIRE, "agent");
            asm volatile("s_waitcnt vmcnt(0)" ::: "memory");
        }
    }
    __syncthreads();
}

__device__ __forceinline__ int opq_bx() { int b = blockIdx.x; asm volatile("" : "+s"(b)); return b; }
__device__ __forceinline__ int opq_i(int v) { asm volatile("" : "+s"(v)); return v; }
__device__ __forceinline__ unsigned char* opq_p(unsigned char* p) { unsigned long long a = (unsigned long long)p; asm volatile("" : "+s"(a)); return (unsigned char*)(GAS unsigned char*)a; }
__device__ __forceinline__ int opq_v(int v) { asm volatile("" : "+v"(v)); return v; }
struct Frame {
    LAS unsigned char* lds;
    volatile LAS unsigned* MISC;
    int tid, lane, wave, vcu, G;
    float* out; unsigned char* ws;
};
#define CAS __attribute__((address_space(4)))
__device__ __forceinline__ const float* inp(int i) {
    const CAS char* ka = (const CAS char*)__builtin_amdgcn_kernarg_segment_ptr(); asm volatile("" : "+s"(ka));
    const GAS float* p = *(const GAS float* const CAS*)(ka + 8 * i);
    return (const float*)p;
}
__device__ __forceinline__ float wave_sum(float v) {
    v += __int_as_float(__builtin_amdgcn_ds_swizzle(__float_as_int(v), 0x041F));
    v += __int_as_float(__builtin_amdgcn_ds_swizzle(__float_as_int(v), 0x081F));
    v += __int_as_float(__builtin_amdgcn_ds_swizzle(__float_as_int(v), 0x101F));
    v += __int_as_float(__builtin_amdgcn_ds_swizzle(__float_as_int(v), 0x201F));
    v += __int_as_float(__builtin_amdgcn_ds_swizzle(__float_as_int(v), 0x401F));
    const auto rr = __builtin_amdgcn_permlane32_swap(__float_as_uint(v), __float_as_uint(v), false, false);
    return __uint_as_float(rr[0]) + __uint_as_float(rr[1]);
}
__device__ __forceinline__ void transpose_item(const float* W, int N, bf16* WT, int ldo, const float* scale, LAS float* scr, int item, int nblk, int lane) {
    const int kb = item / nblk, nb = item % nblk, k0 = 64 * kb, n0 = 32 * nb;
    float v[32];
#pragma unroll
    for (int i = 0; i < 32; ++i) v[i] = __builtin_nontemporal_load(W + (size_t)(k0 + 2 * i + (lane >> 5)) * N + n0 + (lane & 31));
    if (scale) {
#pragma unroll
        for (int i = 0; i < 32; ++i) v[i] *= scale[k0 + 2 * i + (lane >> 5)]; }
#pragma unroll
    for (int i = 0; i < 32; ++i) scr[(2 * i + (lane >> 5)) * 33 + (lane & 31)] = v[i];
    LDS_WAIT(); asm volatile("" ::: "memory");
    const int c = lane & 7;
#pragma unroll
    for (int j = 0; j < 4; ++j) { const int n = (lane >> 3) + 8 * j; const LAS float* s = scr + (8 * c) * 33 + n;
        v4u o; o.x = pk2(s[0 * 33], s[1 * 33]); o.y = pk2(s[2 * 33], s[3 * 33]); o.z = pk2(s[4 * 33], s[5 * 33]); o.w = pk2(s[6 * 33], s[7 * 33]);
        *(GAS v4u*)(WT + (size_t)(n0 + n) * ldo + k0 + 8 * c) = o; }
    LDS_WAIT(); asm volatile("" ::: "memory");
}
__device__ __forceinline__ unsigned char* arena_of(Frame& F, int L) { return L < 2 ? (unsigned char*)F.out + (size_t)L * ARENA_BYTES : F.ws + WS_ARENA + (size_t)(L - 2) * ARENA_BYTES; }
constexpr int CI_W1 = (DM / 64) * (FF / 32), CI_W2 = (FF / 64) * (DM / 32);
constexpr int CI_ATT_A = (DM / 64) * (3 * DM / 32), CI_ATT_B = (DM / 64) * (DM / 32), CI_ATT = CI_ATT_A + CI_ATT_B + CI_W1 + CI_W2;
constexpr int CI_REC_A = (DM / 64) * (2 * DM / 32), CI_REC_G = 512, CI_REC_B = (DM / 64) * (DM / 32), CI_REC = CI_REC_A + CI_REC_G + CI_REC_B + CI_W1 + CI_W2;
struct ConvPtrs { const float *nmix, *nmlp, *wqkv, *wo, *win, *cw, *wga, *wgx, *wro, *w1, *w2; };
__device__ __forceinline__ void convert_item(Frame& F, const ConvPtrs& P, int L, int r, LAS float* scr) {
    const int j = L >> 1;
    unsigned char* ar = arena_of(F, L);
    const float* w1 = P.w1 + (size_t)L * DM * FF; const float* w2 = P.w2 + (size_t)L * FF * DM;
    const float* gmix = P.nmix + L * DM; const float* gmlp = P.nmlp + L * DM;
    if ((L & 1) == 0) {
        const float* wqkv = P.wqkv + (size_t)j * DM * 3 * DM; const float* wo = P.wo + (size_t)j * DM * DM;
        if (r < CI_ATT_A) { transpose_item(wqkv, 3 * DM, (bf16*)(ar + AR_MIX), DM, gmix, scr, r, 3 * DM / 32, F.lane); return; } r -= CI_ATT_A;
        if (r < CI_ATT_B) { transpose_item(wo, DM, (bf16*)(ar + AR_WO), DM, nullptr, scr, r, DM / 32, F.lane); return; } r -= CI_ATT_B;
    } else {
        const float* win = P.win + (size_t)j * DM * 2 * DM; const float* wro = P.wro + (size_t)j * DM * DM;
        const float* wga = P.wga + (size_t)j * 8 * 128 * 128; const float* wgx = P.wgx + (size_t)j * 8 * 128 * 128; const float* cw = P.cw + (size_t)j * 4 * DM;
        if (r < CI_REC_A) { transpose_item(win, 2 * DM, (bf16*)(ar + AR_MIX), DM, gmix, scr, r, 2 * DM / 32, F.lane); return; } r -= CI_REC_A;
        if (r < CI_REC_G) { const int sub = r & 7, q = r >> 3, tap = q & 3, gate = (q >> 2) & 1, n = q >> 3;
            transpose_item((gate ? wgx : wga) + (size_t)n * 128 * 128, 128, (bf16*)(ar + AR_WG) + (size_t)(n * 256 + gate * 128) * 512 + tap * 128, 512, cw + tap * DM + n * 128, scr, sub, 4, F.lane); return; } r -= CI_REC_G;
        if (r < CI_REC_B) { transpose_item(wro, DM, (bf16*)(ar + AR_WO), DM, nullptr, scr, r, DM / 32, F.lane); return; } r -= CI_REC_B;
    }
    if (r < CI_W1) { transpose_item(w1, FF, (bf16*)(ar + AR_W1), DM, gmlp, scr, r, FF / 32, F.lane); return; } r -= CI_W1;
    transpose_item(w2, DM, (bf16*)(ar + AR_W2), FF, nullptr, scr, r, DM / 32, F.lane);
}
__device__ __forceinline__ void convert_all(Frame& F) {
    LAS float* scr = (LAS float*)(F.lds + RING_OFF + F.wave * 16384);
    const int gw = F.vcu * NWAVES + F.wave, NGW = F.G * NWAVES;
    const ConvPtrs P{inp(1), inp(2), inp(3), inp(4), inp(6), inp(8), inp(10), inp(12), inp(15), inp(17), inp(18)};
    for (int it = gw; it < 2 * (CI_ATT + CI_REC); it += NGW) {
        const int pair = it / (CI_ATT + CI_REC), r = it % (CI_ATT + CI_REC);
        if (r < CI_ATT) convert_item(F, P, 2 * pair, r, scr); else convert_item(F, P, 2 * pair + 1, r - CI_ATT, scr);
    }
}
__device__ __forceinline__ void p0_prologue(Frame& F) {
    convert_all(F);
    const int gt = F.vcu * (NWAVES * 64) + F.tid;
    if (gt < 2 * NH * 320) {
        const int i = gt % 320, jh = gt / 320; const float* rel = inp(5);
        ((float*)(F.ws + WS_TEXT))[gt] = rel[(size_t)jh * 257 + (i < 256 ? i : 256)] * 1.4426950408889634f;
    } else if (gt >= 16384 && gt < 16384 + 2 * DM) {
        const int q = gt - 16384, j = q >> 10, ch = q & 1023, n = ch >> 7, e = ch & 127;
        const float* cb = inp(9) + j * DM; const float* cw = inp(8) + (size_t)j * 4 * DM;
        const float* wga = inp(10) + ((size_t)j * 8 + n) * 128 * 128; const float* wgx = inp(12) + ((size_t)j * 8 + n) * 128 * 128;
        float sa = inp(11)[j * DM + ch], sx = inp(13)[j * DM + ch];
        for (int c = 0; c < 128; ++c) { const float cv = cb[n * 128 + c]; sa += cv * wga[c * 128 + e]; sx += cv * wgx[c * 128 + e]; }
        const float Lp = inp(14)[j * DM + ch];
        float* g = (float*)(F.ws + WS_GC) + (size_t)q * 8;
        g[0] = sa; g[1] = sx; g[2] = cb[ch]; g[3] = -8.0f * log1pf(expf(-Lp)) * 1.4426950408889634f;
        g[4] = cw[ch]; g[5] = cw[DM + ch]; g[6] = cw[2 * DM + ch]; g[7] = cw[3 * DM + ch];
    }
    const int gw = F.vcu * NWAVES + F.wave, NGW = F.G * NWAVES;
    const float* x = inp(0); bf16* hb = (bf16*)(F.ws + WS_HB); float* ssq = (float*)(F.ws + WS_SSQ);
    for (int m = gw; m < TOK; m += NGW) {
        const GAS f32x4* xr = (const GAS f32x4*)(x + (size_t)m * DM) + F.lane;
        f32x4 v[4]; float s = 0.f;
#pragma unroll
        for (int jj = 0; jj < 4; ++jj) { v[jj] = xr[64 * jj]; s += (v[jj].x * v[jj].x + v[jj].y * v[jj].y) + (v[jj].z * v[jj].z + v[jj].w * v[jj].w); }
        s = wave_sum(s);
        bf16* hp = hb + (size_t)(m >> 8) * (256 * DM) + (size_t)(m & 255) * 64;
#pragma unroll
        for (int jj = 0; jj < 4; ++jj) *(GAS unsigned long long*)(hp + (size_t)((F.lane >> 4) + 4 * jj) * pg8::KT + 4 * (F.lane & 15)) = (unsigned long long)pk2(v[jj].x, v[jj].y) | ((unsigned long long)pk2(v[jj].z, v[jj].w) << 32);
        if (F.lane < 4) ssq[(size_t)F.lane * TOK + m] = (F.lane == 0) ? s : 0.f;
    }
}
__device__ __forceinline__ void final_norm(Frame& F) {
    const int gw = F.vcu * NWAVES + F.wave, NGW = F.G * NWAVES; const float* gf = inp(19); const bf16* hb = (const bf16*)(F.ws + WS_HB);
    f32x4 g[4];
#pragma unroll
    for (int jj = 0; jj < 2; ++jj) { g[2 * jj] = *(const f32x4*)(gf + 512 * jj + 8 * F.lane); g[2 * jj + 1] = *(const f32x4*)(gf + 512 * jj + 8 * F.lane + 4); }
    for (int m = gw; m < TOK; m += NGW) {
        f32x4 v[4]; float s = 0.f;
#pragma unroll
        for (int jj = 0; jj < 2; ++jj) { const v4u r = *(const GAS v4u*)(hb + (size_t)(m >> 8) * (256 * DM) + (size_t)((F.lane >> 3) + 8 * jj) * pg8::KT + (size_t)(m & 255) * 64 + 8 * (F.lane & 7));
            v[2 * jj] = (f32x4){pg8::bf_lo(r.x), pg8::bf_hi(r.x), pg8::bf_lo(r.y), pg8::bf_hi(r.y)}; v[2 * jj + 1] = (f32x4){pg8::bf_lo(r.z), pg8::bf_hi(r.z), pg8::bf_lo(r.w), pg8::bf_hi(r.w)}; }
#pragma unroll
        for (int q = 0; q < 4; ++q) s += (v[q].x * v[q].x + v[q].y * v[q].y) + (v[q].z * v[q].z + v[q].w * v[q].w);
        const float rstd = __builtin_amdgcn_rsqf(wave_sum(s) * (1.0f / DM) + 1e-6f);
#pragma unroll
        for (int jj = 0; jj < 2; ++jj) { GAS f32x4* o = (GAS f32x4*)(F.out + (size_t)m * DM + 512 * jj + 8 * F.lane); o[0] = v[2 * jj] * rstd * g[2 * jj]; o[1] = v[2 * jj + 1] * rstd * g[2 * jj + 1]; }
    }
}
__device__ __forceinline__ void scan_phase(Frame& F, unsigned char* big, const float* gc) {
    LAS float* sA = (LAS float*)(F.lds + RING_OFF);
    LAS float* sH = sA + 1024;
    LAS float* sC = sH + 1024;
    for (int item = opq_i(F.vcu); item < BATCH * 32; item += F.G) {
        const int tid = opq_v(pg8::tid_of(F.wave)); const int b = item >> 5, cg = item & 31, cp = tid & 15, seg = tid >> 4;
        const int ch = cg * 32 + 2 * cp;
        const f32x4 k0a = *(const f32x4*)(gc + (size_t)ch * 8), k0b = *(const f32x4*)(gc + (size_t)ch * 8 + 4), k1a = *(const f32x4*)(gc + (size_t)(ch + 1) * 8), k1b = *(const f32x4*)(gc + (size_t)(ch + 1) * 8 + 4);
        const float cb0 = k0a[2], cb1 = k1a[2];
        if (tid < 32) sC[tid] = 0.f;
#pragma unroll 1
        for (int hf = 0; hf < 2; ++hf) {
            const int t0 = hf * 1024 + seg * 32;
            const unsigned char* pan = big + (size_t)(b * 8 + (t0 >> 8)) * pg8::PANEL_BYTES;
            const size_t eo = (size_t)(ch >> 6) * pg8::KT + (size_t)(t0 & 255) * 64 + (ch & 63), eox = (size_t)(ch >> 6) * pg8::KTX + (size_t)(t0 & 255) * 64 + (ch & 63);
            const unsigned* pa = (const unsigned*)((const bf16*)(pan + pg8::PO_AL) + eo); const unsigned* pb = (const unsigned*)((const bf16*)(pan + pg8::PO_BQ) + eo);
            const unsigned* py = (const unsigned*)((const bf16*)(pan + pg8::PO_Y) + eo); const unsigned* px = (const unsigned*)((const bf16*)(pan + pg8::PO_X) + eox);
            unsigned ua[32], ub[32], uy[32], ux[35];
#pragma unroll
            for (int s = 0; s < 35; ++s) ux[s] = px[(size_t)s * 32];
#pragma unroll
            for (int s = 0; s < 32; ++s) { ua[s] = pa[(size_t)s * 32]; ub[s] = pb[(size_t)s * 32]; }
#pragma unroll
            for (int s = 0; s < 32; ++s) uy[s] = py[(size_t)s * 32];
            float A0 = 1.f, A1 = 1.f, H0 = 0.f, H1 = 0.f;
#pragma unroll
            for (int s = 0; s < 32; ++s) {
                const float a0 = __builtin_amdgcn_exp2f(pg8::bf_lo(ua[s])), a1 = __builtin_amdgcn_exp2f(pg8::bf_hi(ua[s]));
                const float xc0 = cb0 + k0b[0] * pg8::bf_lo(ux[s]) + k0b[1] * pg8::bf_lo(ux[s + 1]) + k0b[2] * pg8::bf_lo(ux[s + 2]) + k0b[3] * pg8::bf_lo(ux[s + 3]);
                const float xc1 = cb1 + k1b[0] * pg8::bf_hi(ux[s]) + k1b[1] * pg8::bf_hi(ux[s + 1]) + k1b[2] * pg8::bf_hi(ux[s + 2]) + k1b[3] * pg8::bf_hi(ux[s + 3]);
                H0 = a0 * H0 + pg8::bf_lo(ub[s]) * xc0; H1 = a1 * H1 + pg8::bf_hi(ub[s]) * xc1; A0 *= a0; A1 *= a1; }
            sA[seg * 32 + 2 * cp] = A0; sA[seg * 32 + 2 * cp + 1] = A1; sH[seg * 32 + 2 * cp] = H0; sH[seg * 32 + 2 * cp + 1] = H1;
            __syncthreads();
            float c0 = sC[2 * cp], c1 = sC[2 * cp + 1];
            for (int s2 = 0; s2 < seg; ++s2) { c0 = sA[s2 * 32 + 2 * cp] * c0 + sH[s2 * 32 + 2 * cp]; c1 = sA[s2 * 32 + 2 * cp + 1] * c1 + sH[s2 * 32 + 2 * cp + 1]; }
            unsigned* po = (unsigned*)((bf16*)(pan + pg8::PO_G) + eo);
#pragma unroll
            for (int s = 0; s < 32; ++s) {
                const float a0 = __builtin_amdgcn_exp2f(pg8::bf_lo(ua[s])), a1 = __builtin_amdgcn_exp2f(pg8::bf_hi(ua[s]));
                const float xc0 = cb0 + k0b[0] * pg8::bf_lo(ux[s]) + k0b[1] * pg8::bf_lo(ux[s + 1]) + k0b[2] * pg8::bf_lo(ux[s + 2]) + k0b[3] * pg8::bf_lo(ux[s + 3]);
                const float xc1 = cb1 + k1b[0] * pg8::bf_hi(ux[s]) + k1b[1] * pg8::bf_hi(ux[s + 1]) + k1b[2] * pg8::bf_hi(ux[s + 2]) + k1b[3] * pg8::bf_hi(ux[s + 3]);
                c0 = a0 * c0 + pg8::bf_lo(ub[s]) * xc0; c1 = a1 * c1 + pg8::bf_hi(ub[s]) * xc1;
                po[(size_t)s * 32] = pg8::cvt_pk_bf16(c0 * pg8::bf_lo(uy[s]), c1 * pg8::bf_hi(uy[s])); }
            __syncthreads();
            if (seg == 31) { sC[2 * cp] = c0; sC[2 * cp + 1] = c1; }
            __syncthreads();
        }
    }
}

struct Args { const float* in[20]; float* out; unsigned char* ws; int n_sub; int pad; };
__global__ void __launch_bounds__(NWAVES * 64, 2) mega_fwd(Args args) {
    extern __shared__ __attribute__((aligned(16))) unsigned char lds[];
    Frame F;
    F.lds = (LAS unsigned char*)lds;
    F.MISC = (volatile LAS unsigned*)(F.lds + MISC_OFF);
    F.tid = threadIdx.x; F.lane = F.tid & 63; F.wave = __builtin_amdgcn_readfirstlane(F.tid >> 6);
    F.G = gridDim.x; { const int bx = blockIdx.x; F.vcu = (F.G % 8 == 0) ? (bx % 8) * (F.G / 8) + bx / 8 : bx; }
    F.out = args.out; F.ws = args.ws;
    unsigned char* ws = args.ws;
    for (int u = F.tid; u < (LDS_BYTES - LDSCTL_OFF) / 4; u += NWAVES * 64) ((LAS unsigned*)(F.lds + LDSCTL_OFF))[u] = 0u;
    __syncthreads();
    XcdBarrier bar = xcd_barrier_post((unsigned*)(ws + WS_CTL) + CW_BAR, F.MISC + 8);
#define GRID_BAR() xcd_barrier(bar, F.wave)
    group_barrier_post((unsigned*)(ws + WS_CTL), blockIdx.x & 7u);
    group_barrier_post((unsigned*)(ws + WS_CTL), 8u + (blockIdx.x & 7u) * 8u + ((blockIdx.x >> 3) & 7u));
#define GROUP_BAR() group_barrier((unsigned*)(ws_ + WS_CTL), (unsigned)opq_bx() & 7u, F.MISC + 10, F.wave)
#define QUAD_BAR() group_barrier((unsigned*)(ws_ + WS_CTL), 8u + ((unsigned)opq_bx() & 7u) * 8u + (((unsigned)opq_bx() >> 3) & 7u), F.MISC + 12, F.wave)


    p0_prologue(F);
    GRID_BAR();

    const int n_sub = args.n_sub;
    for (int sub = 0; sub < n_sub; ++sub) {
        const int L = sub >> 1, j = L >> 1;
        F.vcu = opq_i(F.vcu);
        unsigned char* ws_ = opq_p(args.ws);
        bf16* HB = (bf16*)(ws_ + WS_HB); float* SSQ = (float*)(ws_ + WS_SSQ); unsigned char* BIG = ws_ + WS_BIG;
        unsigned char* ar = arena_of(F, L);
        pg8::Gemm gr; const float* rbias = nullptr;
        if ((sub & 1) == 0) {
            if ((L & 1) == 0) {
                { pg8::Gemm g{(const char*)HB, (size_t)256 * DM * 2, (const bf16*)(ar + AR_MIX), DM, 64, 32768}; pg8::StaticOrder S; S.init(TOK, 3 * DM, F.G, opq_bx());
                  pg8::EpiQKV E{BIG, SSQ};
                  pg8::gemm_phase<pg8::EpiQKV, 0, true, true>(F.lds + RING_OFF, g, S, E, F.wave); }
                GROUP_BAR();
                { const int vc = opq_i(F.vcu); const int bh = vc >> 1, half = vc & 1; const float* tab = (const float*)(ws_ + WS_TEXT) + ((size_t)j * NH + (bh & 15)) * 320;
                  att::attn_table(tab, F.lds + RING_OFF, F.wave);
                  att::attn_stream(bh >> 4, bh & 15, half, BIG, tab, F.lds + RING_OFF, F.wave); }
                GROUP_BAR();
                gr = pg8::Gemm{(const char*)(BIG + pg8::PO_O), pg8::PANEL_BYTES, (const bf16*)(ar + AR_WO), DM, 64, 32768};
            } else {
                if (opq_bx() < BATCH) { const int tz = pg8::tid_of(F.wave); if (tz < 384) { const unsigned z = (unsigned)opq_v(0);
                    *(GAS v4u*)((bf16*)(BIG + (size_t)(opq_bx() * 8) * pg8::PANEL_BYTES + pg8::PO_X) + (size_t)(tz / 24) * pg8::KTX + (tz % 24) * 8) = (v4u){z, z, z, z}; } }
                { pg8::Gemm g{(const char*)HB, (size_t)256 * DM * 2, (const bf16*)(ar + AR_MIX), DM, 64, 32768}; pg8::StaticOrder S; S.init(TOK, 2 * DM, F.G, opq_bx());
                  pg8::EpiIn E{BIG, SSQ, inp(7) + (size_t)j * 2 * DM};
                  pg8::gemm_phase<pg8::EpiIn, 0, true, true>(F.lds + RING_OFF, g, S, E, F.wave); }
                GROUP_BAR();
                { pg8::Gemm g{(const char*)(BIG + pg8::PO_X), pg8::PANEL_BYTES, (const bf16*)(ar + AR_WG), 512, 64, 0}; pg8::StaticOrder S; S.init(TOK, 2 * DM, F.G, opq_bx());
                  pg8::EpiGate E{BIG, (const float*)(ws_ + WS_GC) + (size_t)j * DM * 8};
                  pg8::gemm_phase<pg8::EpiGate, 1, true, true>(F.lds + RING_OFF, g, S, E, F.wave); }
                GROUP_BAR();
                scan_phase(F, BIG, (const float*)(ws_ + WS_GC) + (size_t)j * DM * 8);
                GROUP_BAR();
                gr = pg8::Gemm{(const char*)(BIG + pg8::PO_G), pg8::PANEL_BYTES, (const bf16*)(ar + AR_WO), DM, 64, 32768}; rbias = inp(16) + (size_t)j * DM;
            }
        } else {
            { pg8::Gemm g{(const char*)HB, (size_t)256 * DM * 2, (const bf16*)(ar + AR_W1), DM, 64, 32768}; pg8::StaticOrder S; S.init(TOK, FF, F.G, opq_bx());
              pg8::EpiUp E{BIG, SSQ};
              pg8::gemm_phase<pg8::EpiUp, 0, true, true>(F.lds + RING_OFF, g, S, E, F.wave); }
            QUAD_BAR();
            gr = pg8::Gemm{(const char*)(BIG + pg8::PO_Z), pg8::PANEL_BYTES, (const bf16*)(ar + AR_W2), FF, 64, 32768};
        }
        { pg8::StaticOrder S; S.init(TOK, DM, F.G, opq_bx());
          pg8::EpiRes E{HB, SSQ, rbias};
          pg8::gemm_phase<pg8::EpiRes, 0, false, true>(F.lds + RING_OFF, gr, S, E, F.wave); }
        QUAD_BAR();
    }
    GRID_BAR();
    F.tid = pg8::tid_of(F.wave); F.lane = F.tid & 63;
    if (n_sub == 2 * DEPTH) { final_norm(F); }
}

#if FAST_SUBS < 8
namespace nv {
constexpr int D = 1024, B = 8, S = 2048, DEPTH = 4, H = 16, HD = 64, CH = 64, LEFT = 8, BAND = 9 * 64, MAXREL = 128, NREL = 257;
constexpr int DR = 1024, NB = 8, RB = 128, FF = 4096;

__global__ void rmsnorm_k(const float* x, const float* __restrict__ g, float* y) {
    const int row = blockIdx.x, tid = threadIdx.x;
    const float* xr = x + (size_t)row * D;
    float v[4], s = 0.f;
#pragma unroll
    for (int i = 0; i < 4; ++i) { v[i] = xr[tid + 256 * i]; s += v[i] * v[i]; }
    __shared__ float red[256];
    red[tid] = s; __syncthreads();
    for (int o = 128; o > 0; o >>= 1) { if (tid < o) red[tid] += red[tid + o]; __syncthreads(); }
    const float rstd = rsqrtf(red[0] / D + 1e-6f);
#pragma unroll
    for (int i = 0; i < 4; ++i) y[(size_t)row * D + tid + 256 * i] = v[i] * rstd * g[tid + 256 * i];
}

__global__ void gemm_k(const float* __restrict__ A, int lda, const float* __restrict__ Bm, int ldb, float* C, int ldc,
                       const float* __restrict__ bias, const float* res, int ldr, int K, int act) {
    __shared__ float As[16][64 + 1], Bs[16][64 + 1];
    const int tx = threadIdx.x & 15, ty = threadIdx.x >> 4, m0 = blockIdx.y * 64, n0 = blockIdx.x * 64;
    float acc[4][4] = {};
    for (int k0 = 0; k0 < K; k0 += 16) {
        for (int i = threadIdx.x; i < 64 * 16; i += 256) { const int r = i >> 4, c = i & 15; As[c][r] = A[(size_t)(m0 + r) * lda + k0 + c]; }
        for (int i = threadIdx.x; i < 16 * 64; i += 256) { const int r = i >> 6, c = i & 63; Bs[r][c] = Bm[(size_t)(k0 + r) * ldb + n0 + c]; }
        __syncthreads();
#pragma unroll
        for (int kk = 0; kk < 16; ++kk) {
            float a[4], b[4];
#pragma unroll
            for (int i = 0; i < 4; ++i) { a[i] = As[kk][ty * 4 + i]; b[i] = Bs[kk][tx * 4 + i]; }
#pragma unroll
            for (int i = 0; i < 4; ++i)
#pragma unroll
                for (int j = 0; j < 4; ++j) acc[i][j] += a[i] * b[j];
        }
        __syncthreads();
    }
#pragma unroll
    for (int i = 0; i < 4; ++i)
#pragma unroll
        for (int j = 0; j < 4; ++j) {
            const int r = m0 + ty * 4 + i, c = n0 + tx * 4 + j;
            float v = acc[i][j];
            if (bias) v += bias[c];
            if (act == 1) { v = fmaxf(v, 0.f); v = v * v; }
            if (res) v += res[(size_t)r * ldr + c];
            C[(size_t)r * ldc + c] = v;
        }
}

__global__ void __launch_bounds__(64) attn_k(const float* __restrict__ qkv, const float* __restrict__ table, float* __restrict__ o) {
    const int c = blockIdx.x, h = blockIdx.y, qi = threadIdx.x, t = c * CH + qi;
    float q[HD], acc[HD];
#pragma unroll
    for (int d = 0; d < HD; ++d) { q[d] = qkv[(size_t)t * 3 * D + h * HD + d]; acc[d] = 0.f; }
    const int k0 = c * CH - LEFT * CH;
    float m = -1e30f;
    for (int j = 0; j < BAND; ++j) {
        const int kp = k0 + j; if (kp < 0) continue;
        const float* kr = qkv + (size_t)kp * 3 * D + D + h * HD;
        float s = 0.f;
    #pragma unroll
    for (int d = 0; d < HD; ++d) s += q[d] * kr[d];
        int rel = t - kp; rel = rel < -MAXREL ? -MAXREL : (rel > MAXREL ? MAXREL : rel);
        s = s * 0.125f + table[h * NREL + rel + MAXREL];
        m = fmaxf(m, s);
    }
    float l = 0.f;
    for (int j = 0; j < BAND; ++j) {
        const int kp = k0 + j; if (kp < 0) continue;
        const float* kr = qkv + (size_t)kp * 3 * D + D + h * HD;
        const float* vr = qkv + (size_t)kp * 3 * D + 2 * D + h * HD;
        float s = 0.f;
    #pragma unroll
    for (int d = 0; d < HD; ++d) s += q[d] * kr[d];
        int rel = t - kp; rel = rel < -MAXREL ? -MAXREL : (rel > MAXREL ? MAXREL : rel);
        s = s * 0.125f + table[h * NREL + rel + MAXREL];
        const float p = expf(s - m);
        l += p;
    #pragma unroll
    for (int d = 0; d < HD; ++d) acc[d] += p * vr[d];
    }
    const float il = 1.f / l;
#pragma unroll
    for (int d = 0; d < HD; ++d) o[(size_t)t * D + h * HD + d] = acc[d] * il;
}

__global__ void conv_k(const float* __restrict__ u, const float* __restrict__ cw, const float* __restrict__ cb, float* __restrict__ xc) {
    const int t = blockIdx.x;
    for (int ch = threadIdx.x; ch < DR; ch += 256) {
        float v = cb[ch];
        for (int tap = 0; tap < 4; ++tap) { const int tt = t - 3 + tap; if (tt >= 0) v += u[(size_t)tt * 2 * DR + ch] * cw[tap * DR + ch]; }
        xc[(size_t)t * DR + ch] = v;
    }
}

__global__ void gates_k(const float* __restrict__ xc, const float* __restrict__ wga, const float* __restrict__ bga, const float* __restrict__ wgx,
                        const float* __restrict__ bgx, const float* __restrict__ ap, float* __restrict__ a, float* __restrict__ bq) {
    const int t = blockIdx.x;
    __shared__ float xr[DR];
    for (int i = threadIdx.x; i < DR; i += 256) xr[i] = xc[(size_t)t * DR + i];
    __syncthreads();
    for (int e = threadIdx.x; e < DR; e += 256) {
        const int n = e / RB, ee = e % RB;
        float sa = bga[e], sx = bgx[e];
        for (int c2 = 0; c2 < RB; ++c2) { const float xv = xr[n * RB + c2]; sa += xv * wga[((size_t)n * RB + c2) * RB + ee]; sx += xv * wgx[((size_t)n * RB + c2) * RB + ee]; }
        const float r = 1.f / (1.f + expf(-sa)), ig = 1.f / (1.f + expf(-sx));
        const float L = ap[e];
        const float sp = log1pf(expf(-L));
        const float log_a = -8.f * r * sp;
        const float av = expf(log_a);
        const float mult = sqrtf(-expm1f(2.f * log_a));
        a[(size_t)t * DR + e] = av;
        bq[(size_t)t * DR + e] = mult * (ig * xr[e]);
    }
}

__global__ void scan_k(const float* __restrict__ a, const float* __restrict__ bq, const float* __restrict__ u, float* __restrict__ out) {
    const int ch = blockIdx.x * blockDim.x + threadIdx.x;
    float hs = 0.f;
    for (int t = 0; t < S; ++t) {
        hs = a[(size_t)t * DR + ch] * hs + bq[(size_t)t * DR + ch];
        const float y = u[(size_t)t * 2 * DR + DR + ch];
        const float gy = 0.5f * y * (1.f + tanhf(0.7978845608028654f * (y + 0.044715f * y * y * y)));
        out[(size_t)t * DR + ch] = hs * gy;
    }
}
}
#endif
#if FAST_SUBS < 8
__global__ void dbg_bf2f(const unsigned short* in, float* out, size_t n) { for (size_t i = (size_t)blockIdx.x * blockDim.x + threadIdx.x; i < n; i += (size_t)gridDim.x * blockDim.x) { const size_t m = i >> 10, c = i & 1023; out[i] = __uint_as_float((unsigned)in[(m >> 8) * (256 * 1024) + (c >> 6) * (256 * 64) + (m & 255) * 64 + (c & 63)] << 16); } }
#endif
extern "C" void kernel_launch(void* const* d_in, const int* in_sizes, int n_in, void* d_out, int out_size, void* d_ws, size_t ws_size, hipStream_t stream) {
    static int grid = 0;
    if (grid == 0) {
        int dev = 0, cus = 0;
        if (n_in != 20 || out_size != TOK * DM || ws_size < WS_END) { fprintf(stderr, "kernel_launch: unexpected shapes (n_in %d out %d ws %zu)\n", n_in, out_size, ws_size); grid = -1; return; }
        if (hipGetDevice(&dev) != hipSuccess || hipDeviceGetAttribute(&cus, hipDeviceAttributeMultiprocessorCount, dev) != hipSuccess) { grid = -1; return; }
        if (hipFuncSetAttribute((const void*)mega_fwd, hipFuncAttributeMaxDynamicSharedMemorySize, LDS_BYTES) != hipSuccess) { fprintf(stderr, "kernel_launch: hipFuncSetAttribute failed\n"); grid = -1; return; }
        (void)hipGetLastError();
        grid = cus;
        if (grid != 256) fprintf(stderr, "kernel_launch: %d CUs; this kernel is built for 256\n", grid);
    }
    if (grid < 0) return;
    (void)hipMemsetAsync((char*)d_ws + WS_CTL, 0, CTL_ZERO_BYTES, stream);
    Args a{};
    for (int i = 0; i < 20; ++i) a.in[i] = (const float*)d_in[i];
    a.out = (float*)d_out; a.ws = (unsigned char*)d_ws; a.n_sub = FAST_SUBS; a.pad = 0;
    hipLaunchKernelGGL(mega_fwd, dim3(grid), dim3(NWAVES * 64), LDS_BYTES, stream, a);
#if FAST_SUBS < 8
    {
        using namespace nv;
        const float* norm_mix = (const float*)d_in[1]; const float* norm_mlp = (const float*)d_in[2];
        const float* w_qkv = (const float*)d_in[3]; const float* w_o = (const float*)d_in[4]; const float* rel = (const float*)d_in[5];
        const float* r_win = (const float*)d_in[6]; const float* r_bin = (const float*)d_in[7]; const float* r_cw = (const float*)d_in[8]; const float* r_cb = (const float*)d_in[9];
        const float* r_wga = (const float*)d_in[10]; const float* r_bga = (const float*)d_in[11]; const float* r_wgx = (const float*)d_in[12]; const float* r_bgx = (const float*)d_in[13];
        const float* r_ap = (const float*)d_in[14]; const float* r_wo = (const float*)d_in[15]; const float* r_bo = (const float*)d_in[16];
        const float* w1 = (const float*)d_in[17]; const float* w2 = (const float*)d_in[18]; const float* norm_final = (const float*)d_in[19];
        float* h = (float*)d_out; float* wsf = (float*)((char*)d_ws + 64 * MiB);
        float* hn = wsf; float* big = hn + (size_t)S * D; float* t1 = big + (size_t)S * FF; float* t2 = t1 + (size_t)S * D; float* t3 = t2 + (size_t)S * D;
        if (FAST_SUBS == 0) (void)hipMemcpyAsync(h, d_in[0], (size_t)B * S * D * 4, hipMemcpyDeviceToDevice, stream);
        else dbg_bf2f<<<4096, 256, 0, stream>>>((const unsigned short*)((char*)d_ws + WS_HB), h, (size_t)B * S * D);
        for (int sub = FAST_SUBS; sub < 8; ++sub) {
            const int layer = sub >> 1, j = layer / 2;
            for (int b = 0; b < B; ++b) {
                float* hb = h + (size_t)b * S * D;
                if ((sub & 1) == 0) {
                    rmsnorm_k<<<S, 256, 0, stream>>>(hb, norm_mix + layer * D, hn);
                    if (layer % 2 == 0) {
                        gemm_k<<<dim3(3 * D / 64, S / 64), 256, 0, stream>>>(hn, D, w_qkv + (size_t)j * D * 3 * D, 3 * D, big, 3 * D, nullptr, nullptr, 0, D, 0);
                        attn_k<<<dim3(S / CH, H), 64, 0, stream>>>(big, rel + (size_t)j * H * NREL, t1);
                        gemm_k<<<dim3(D / 64, S / 64), 256, 0, stream>>>(t1, D, w_o + (size_t)j * D * D, D, hb, D, nullptr, hb, D, D, 0);
                    } else {
                        gemm_k<<<dim3(2 * DR / 64, S / 64), 256, 0, stream>>>(hn, D, r_win + (size_t)j * D * 2 * DR, 2 * DR, big, 2 * DR, r_bin + (size_t)j * 2 * DR, nullptr, 0, D, 0);
                        conv_k<<<S, 256, 0, stream>>>(big, r_cw + (size_t)j * 4 * DR, r_cb + (size_t)j * DR, t1);
                        gates_k<<<S, 256, 0, stream>>>(t1, r_wga + (size_t)j * NB * RB * RB, r_bga + (size_t)j * DR, r_wgx + (size_t)j * NB * RB * RB, r_bgx + (size_t)j * DR, r_ap + (size_t)j * DR, t2, t3);
                        scan_k<<<DR / 64, 64, 0, stream>>>(t2, t3, big, t1);
                        gemm_k<<<dim3(D / 64, S / 64), 256, 0, stream>>>(t1, DR, r_wo + (size_t)j * DR * D, D, hb, D, r_bo + (size_t)j * D, hb, D, DR, 0);
                    }
                } else {
                    rmsnorm_k<<<S, 256, 0, stream>>>(hb, norm_mlp + layer * D, hn);
                    gemm_k<<<dim3(FF / 64, S / 64), 256, 0, stream>>>(hn, D, w1 + (size_t)layer * D * FF, FF, big, FF, nullptr, nullptr, 0, D, 1);
                    gemm_k<<<dim3(D / 64, S / 64), 256, 0, stream>>>(big, FF, w2 + (size_t)layer * FF * D, D, hb, D, nullptr, hb, D, FF, 0);
                }
            }
        }
        for (int b = 0; b < B; ++b) { float* hb = h + (size_t)b * S * D; rmsnorm_k<<<S, 256, 0, stream>>>(hb, norm_final, hb); }
    }
#endif
}
```

```cpp
#include <hip/hip_runtime.h>
#include <hip/hip_bf16.h>
#include <cstdio>
#include <cstdint>
#include <math.h>
#ifndef FAST_SUBS
#define FAST_SUBS 8
#endif
namespace pg8 {
#define PG8_LAS __attribute__((address_space(3)))
typedef unsigned short bf16_t;
typedef short bf16x8 __attribute__((ext_vector_type(8)));
typedef float f32x4 __attribute__((ext_vector_type(4)));
typedef float f32x2 __attribute__((ext_vector_type(2)));
typedef unsigned u32x4 __attribute__((ext_vector_type(4)));
typedef unsigned u32x2 __attribute__((ext_vector_type(2)));
constexpr int BM = 256, BK = 64, HALF = 128, HTB = HALF * BK * 2  , STAGE_BYTES = 8 * HTB, NXCD = 8, WGM = 8;
constexpr int TOK = 16384, DMODEL = 1024, SEQL = 2048;
constexpr size_t PANEL_BYTES = 2752512;
constexpr int PO_Z = 0, PO_Q = 0, PO_K = 512 * 1024, PO_V = 1024 * 1024, PO_O = 1536 * 1024, PO_Y = 0, PO_AL = 512 * 1024, PO_BQ = 1024 * 1024, PO_G = 1536 * 1024, PO_X = 2048 * 1024;
static_assert((size_t)PO_X + 259 * 2048 <= PANEL_BYTES, "panel map");
constexpr int KT = 256 * 64, KTX = 259 * 64;

constexpr float RMS_EPS = 1e-6f;
constexpr float C2 = 0.125f * 1.4426950408889634f;

__host__ __device__ __forceinline__ int lds_byte(int r, int c) { const int st = (r >> 4) * 2 + (c >> 5), rr = r & 15, cc = c & 31, ob = rr * 64 + cc * 2; return st * 1024 + (ob ^ (((ob >> 9) & 1) << 5)); }
__host__ __device__ __forceinline__ void stage_rc(int b, int& R, int& C) { const int st = b / 1024, sb = b % 1024, swz = sb ^ (((sb >> 9) & 1) << 5); R = (st >> 1) * 16 + swz / 64; C = (st & 1) * 32 + (swz % 64) / 2; }
__host__ __device__ __forceinline__ int perm32(int rho) { const int n = rho >> 4, i = rho & 15; return 8 * (i >> 2) + 4 * n + (i & 3); }

struct Unit { int pm, pn; };
struct Gemm { const char* A; size_t apstride; const bf16_t* Bt; int K; int lda; int kts; };
template <int MODE> __device__ __forceinline__ const char* a_base(const Gemm& g, const Unit& u) {
    if (MODE == 0) return g.A + (size_t)u.pm * g.apstride;
    return g.A + (size_t)u.pm * g.apstride + (size_t)(2 * u.pn) * (KTX * 2);
}
template <int MODE> __device__ __forceinline__ size_t koff(const Gemm& g, int t) {
    if (MODE == 0) return (size_t)t * (size_t)g.kts;
    return (size_t)(t & 1) * (KTX * 2) + (size_t)(t >> 1) * 128;
}

struct StaticOrder {
    int nM, nN, nwg, G, c;
    __host__ __device__ void init(int M, int N, int G_, int c_) { nM = M / BM; nN = N / BM; nwg = nM * nN; G = G_; c = c_; }
    __host__ __device__ bool next(int i, Unit& u) const {
        const long L = (long)i * G + c; if (L >= nwg) return false;
        int wgid = (int)L; { const int q = nwg / NXCD, r = nwg % NXCD, xcd = wgid % NXCD, off = wgid / NXCD; wgid = (xcd < r ? xcd * (q + 1) : r * (q + 1) + (xcd - r) * q) + off; }
        const int nig = WGM * nN, gid = wgid / nig, fm = gid * WGM, gsz = (nM - fm) < WGM ? (nM - fm) : WGM;
        u.pm = fm + ((wgid % nig) % gsz); u.pn = (wgid % nig) / gsz; return true;
    }
};

__device__ __forceinline__ unsigned cvt_pk_bf16(float lo, float hi) { unsigned r; asm volatile("v_cvt_pk_bf16_f32 %0, %1, %2" : "=v"(r) : "v"(lo), "v"(hi)); return r; }
__device__ __forceinline__ void st16(bf16_t* p, u32x4 v) { *(u32x4*)p = v; }
__device__ __forceinline__ float quarter_sum(float s) {
    s += __int_as_float(__builtin_amdgcn_ds_swizzle(__float_as_int(s), 0x401F));
    const auto rr = __builtin_amdgcn_permlane32_swap(__float_as_uint(s), __float_as_uint(s), false, false);
    return __uint_as_float(rr[0]) + __uint_as_float(rr[1]);
}
__device__ __forceinline__ int tid_of(int wave) { unsigned m = ~0u; asm volatile("" : "+s"(m));
    return wave * 64 + (int)__builtin_amdgcn_mbcnt_hi(m, __builtin_amdgcn_mbcnt_lo(m, 0u)); }
__device__ __forceinline__ float bf_lo(unsigned u) { return __uint_as_float(u << 16); }
__device__ __forceinline__ float bf_hi(unsigned u) { return __uint_as_float(u & 0xffff0000u); }
constexpr int RSTD_LDS_OFF = 131072 + 2048;
__device__ __forceinline__ float rstd_of(const float* ssq, int row) {
    const float s = (ssq[row] + ssq[TOK + row]) + (ssq[2 * TOK + row] + ssq[3 * TOK + row]);
    return __builtin_amdgcn_rsqf(s * (1.0f / DMODEL) + RMS_EPS);
}


struct EpiQKV {
    static constexpr bool PERM = true, AFTER_DRAIN = false, NEED_RSTD = true;
    unsigned char* big; const float* ssq;
    __device__ __forceinline__ void operator()(const f32x4 (&acc)[2][2][4][2], const Unit& u, int wr, int wc, int fr, int fq, const PG8_LAS float* rstdL) const {
        const int t = u.pn >> 2; bf16_t* base = (bf16_t*)(big + (size_t)u.pm * PANEL_BYTES + PO_Q + (size_t)t * (PO_K - PO_Q)); const float sc0 = t == 0 ? C2 : 1.f;
        const int rl0 = wr * 64 + fr; const size_t co = (size_t)(4 * (u.pn & 3) + (wc >> 1)) * KT + 32 * (wc & 1) + 8 * fq;
#pragma unroll
        for (int ai = 0; ai < 2; ++ai)
#pragma unroll
            for (int m = 0; m < 4; ++m) { const int rl = rl0 + ai * HALF + m * 16; const float sc = rstdL[rl] * sc0; bf16_t* rowp = base + co + (size_t)rl * 64;
#pragma unroll
                for (int bj = 0; bj < 2; ++bj) { const f32x4 v0 = acc[ai][bj][m][0] * sc, v1 = acc[ai][bj][m][1] * sc;
                    u32x4 w; w.x = cvt_pk_bf16(v0[0], v0[1]); w.y = cvt_pk_bf16(v0[2], v0[3]); w.z = cvt_pk_bf16(v1[0], v1[1]); w.w = cvt_pk_bf16(v1[2], v1[3]);
                    *(u32x4*)(rowp + (size_t)bj * (2 * KT)) = w; } }
    }
};
struct EpiUp {
    static constexpr bool PERM = true, AFTER_DRAIN = false, NEED_RSTD = true;
    unsigned char* big; const float* ssq;
    __device__ __forceinline__ void operator()(const f32x4 (&acc)[2][2][4][2], const Unit& u, int wr, int wc, int fr, int fq, const PG8_LAS float* rstdL) const {
        bf16_t* base = (bf16_t*)(big + (size_t)u.pm * PANEL_BYTES + PO_Z);
        const int rl0 = wr * 64 + fr; const size_t co = (size_t)(4 * u.pn + (wc >> 1)) * 16384 + 32 * (wc & 1) + 8 * fq;
#pragma unroll
        for (int ai = 0; ai < 2; ++ai)
#pragma unroll
            for (int m = 0; m < 4; ++m) { const int rl = rl0 + ai * HALF + m * 16; const float sc = rstdL[rl]; bf16_t* rowp = base + co + (size_t)rl * 64;
#pragma unroll
                for (int bj = 0; bj < 2; ++bj) { f32x4 v0 = acc[ai][bj][m][0] * sc, v1 = acc[ai][bj][m][1] * sc;
#pragma unroll
                    for (int i = 0; i < 4; ++i) { v0[i] = fmaxf(v0[i], 0.f); v1[i] = fmaxf(v1[i], 0.f); }
                    v0 = v0 * v0; v1 = v1 * v1;
                    u32x4 w; w.x = cvt_pk_bf16(v0[0], v0[1]); w.y = cvt_pk_bf16(v0[2], v0[3]); w.z = cvt_pk_bf16(v1[0], v1[1]); w.w = cvt_pk_bf16(v1[2], v1[3]);
                    st16(rowp + (size_t)bj * 32768, w); } }
    }
};
__device__ __forceinline__ float gelu_tanh(float v) {
    const float z = v * (1.0f + 0.044715f * v * v) * (-2.0f * 0.7978845608028654f * 1.4426950408889634f);
    return v * __builtin_amdgcn_rcpf(1.0f + __builtin_amdgcn_exp2f(z));
}
struct EpiIn {
    static constexpr bool PERM = true, AFTER_DRAIN = false, NEED_RSTD = true;
    unsigned char* big; const float* ssq; const float* bias;
    __device__ __forceinline__ void operator()(const f32x4 (&acc)[2][2][4][2], const Unit& u, int wr, int wc, int fr, int fq, const PG8_LAS float* rstdL) const {
        const bool isy = u.pn >= 4, has_nxt = (u.pm & 7) != 7;
        unsigned char* pan = big + (size_t)u.pm * PANEL_BYTES;
        const int rl0 = wr * 64 + fr, ktl = 4 * (u.pn & 3) + (wc >> 1), cl = 32 * (wc & 1) + 8 * fq, bcol0 = u.pn * BM + wc * 32 + 8 * fq;
        f32x4 bv[2][2];
#pragma unroll
        for (int bj = 0; bj < 2; ++bj)
#pragma unroll
            for (int n = 0; n < 2; ++n) bv[bj][n] = *(const f32x4*)(bias + bcol0 + bj * HALF + 4 * n);
#pragma unroll
        for (int ai = 0; ai < 2; ++ai)
#pragma unroll
            for (int m = 0; m < 4; ++m) { const int rl = rl0 + ai * HALF + m * 16; const float sc = rstdL[rl];
                const size_t kst = isy ? (size_t)KT : (size_t)KTX;
                bf16_t* rowp = isy ? ((bf16_t*)(pan + PO_Y) + (size_t)ktl * KT + (size_t)rl * 64 + cl) : ((bf16_t*)(pan + PO_X) + (size_t)ktl * KTX + (size_t)(rl + 3) * 64 + cl);
                const bool halo = !isy && has_nxt && rl >= BM - 3;
                bf16_t* hrow = (bf16_t*)(pan + PANEL_BYTES + PO_X) + (size_t)ktl * KTX + (size_t)(rl - (BM - 3)) * 64 + cl;
#pragma unroll
                for (int bj = 0; bj < 2; ++bj) { f32x4 v0 = acc[ai][bj][m][0] * sc + bv[bj][0], v1 = acc[ai][bj][m][1] * sc + bv[bj][1];
                    if (isy) {
#pragma unroll
                        for (int i = 0; i < 4; ++i) { v0[i] = gelu_tanh(v0[i]); v1[i] = gelu_tanh(v1[i]); } }
                    u32x4 w; w.x = cvt_pk_bf16(v0[0], v0[1]); w.y = cvt_pk_bf16(v0[2], v0[3]); w.z = cvt_pk_bf16(v1[0], v1[1]); w.w = cvt_pk_bf16(v1[2], v1[3]);
                    *(u32x4*)(rowp + (size_t)bj * 2 * kst) = w;
                    if (halo) *(u32x4*)(hrow + (size_t)bj * 2 * KTX) = w; } }
    }
};
struct EpiGate {
    static constexpr bool PERM = true, AFTER_DRAIN = false, NEED_RSTD = false;
    unsigned char* big; const float* gc;
    __device__ __forceinline__ void operator()(const f32x4 (&acc)[2][2][4][2], const Unit& u, int wr, int wc, int fr, int fq, const PG8_LAS float*) const {
        const int rl0 = wr * 64 + fr, ch0 = u.pn * 128 + wc * 32 + 8 * fq;
        bf16_t* AL = (bf16_t*)(big + (size_t)u.pm * PANEL_BYTES + PO_AL); bf16_t* BQ = (bf16_t*)(big + (size_t)u.pm * PANEL_BYTES + PO_BQ);
        float ba[8], bx[8], c8[8];
#pragma unroll
        for (int i = 0; i < 8; ++i) { const f32x4 c = *(const f32x4*)(gc + (size_t)(ch0 + i) * 8); ba[i] = c[0]; bx[i] = c[1]; c8[i] = c[3]; }
#pragma unroll
        for (int ai = 0; ai < 2; ++ai)
#pragma unroll
            for (int m = 0; m < 4; ++m) { const int row = rl0 + ai * HALF + m * 16;
                float la2[8], bq[8];
#pragma unroll
                for (int i = 0; i < 8; ++i) { const float ga = acc[ai][0][m][i >> 2][i & 3], gx = acc[ai][1][m][i >> 2][i & 3];
                    const float r = __builtin_amdgcn_rcpf(1.0f + __builtin_amdgcn_exp2f(-(ga + ba[i]) * 1.4426950408889634f));
                    const float ig = __builtin_amdgcn_rcpf(1.0f + __builtin_amdgcn_exp2f(-(gx + bx[i]) * 1.4426950408889634f));
                    la2[i] = c8[i] * r;
                    const float om = 1.0f - __builtin_amdgcn_exp2f(2.0f * la2[i]);
                    bq[i] = __builtin_amdgcn_sqrtf(om) * ig; }
                u32x4 wa, wb;
                wa.x = cvt_pk_bf16(la2[0], la2[1]); wa.y = cvt_pk_bf16(la2[2], la2[3]); wa.z = cvt_pk_bf16(la2[4], la2[5]); wa.w = cvt_pk_bf16(la2[6], la2[7]);
                wb.x = cvt_pk_bf16(bq[0], bq[1]); wb.y = cvt_pk_bf16(bq[2], bq[3]); wb.z = cvt_pk_bf16(bq[4], bq[5]); wb.w = cvt_pk_bf16(bq[6], bq[7]);
                const size_t eo = (size_t)(2 * u.pn + (wc >> 1)) * KT + (size_t)row * 64 + 32 * (wc & 1) + 8 * fq;
                *(u32x4*)(AL + eo) = wa; *(u32x4*)(BQ + eo) = wb;
            }
    }
};
struct EpiRes {
    static constexpr bool PERM = true, AFTER_DRAIN = true, NEED_RSTD = false;
    bf16_t* hb; float* ssq; const float* bias;
    __device__ __forceinline__ void prefetch(u32x4 (&pre)[4][2], const Unit& u, int wr, int wc, int fr, int fq) const {
        const bf16_t* hbp = hb + (size_t)u.pm * (BM * DMODEL) + (size_t)(4 * u.pn + (wc >> 1)) * KT + 32 * (wc & 1) + 8 * fq;
#pragma unroll
        for (int m = 0; m < 4; ++m)
#pragma unroll
            for (int bj = 0; bj < 2; ++bj) pre[m][bj] = *(const u32x4*)(hbp + (size_t)(wr * 64 + m * 16 + fr) * 64 + (size_t)bj * (2 * KT));
    }
    __device__ __forceinline__ void fused(f32x4 (&acc)[2][2][4][2], const u32x4 (&pre)[4][2], const Unit& u, int wr, int wc, int fr, int fq, PG8_LAS unsigned char* lds, int wid, int lane) const {
        PG8_LAS float* P = (PG8_LAS float*)lds;
        const int col0 = u.pn * BM + wc * 32 + 8 * fq;
        bf16_t* hbp = hb + (size_t)u.pm * (BM * DMODEL) + (size_t)(4 * u.pn + (wc >> 1)) * KT + 32 * (wc & 1) + 8 * fq;
        f32x4 bv[2][2];
#pragma unroll
        for (int bj = 0; bj < 2; ++bj)
#pragma unroll
            for (int n = 0; n < 2; ++n) bv[bj][n] = bias ? *(const f32x4*)(bias + col0 + bj * HALF + 4 * n) : (f32x4){0.f, 0.f, 0.f, 0.f};
#pragma unroll
        for (int ai = 0; ai < 2; ++ai) {
            u32x4 rr[4][2];
#pragma unroll
            for (int m = 0; m < 4; ++m)
#pragma unroll
                for (int bj = 0; bj < 2; ++bj) rr[m][bj] = (ai == 0) ? pre[m][bj] : *(const u32x4*)(hbp + (size_t)(ai * HALF + wr * 64 + m * 16 + fr) * 64 + (size_t)bj * (2 * KT));
#pragma unroll
            for (int m = 0; m < 4; ++m) { const int rl = ai * HALF + wr * 64 + m * 16 + fr;
                float s = 0.f;
#pragma unroll
                for (int bj = 0; bj < 2; ++bj) { const u32x4 r = rr[m][bj];
                    const f32x4 r0 = (f32x4){bf_lo(r.x), bf_hi(r.x), bf_lo(r.y), bf_hi(r.y)}, r1 = (f32x4){bf_lo(r.z), bf_hi(r.z), bf_lo(r.w), bf_hi(r.w)};
                    const f32x4 v0 = acc[ai][bj][m][0] + bv[bj][0] + r0, v1 = acc[ai][bj][m][1] + bv[bj][1] + r1;
                    s += (v0[0] * v0[0] + v0[1] * v0[1]) + (v0[2] * v0[2] + v0[3] * v0[3]) + (v1[0] * v1[0] + v1[1] * v1[1]) + (v1[2] * v1[2] + v1[3] * v1[3]);
                    u32x4 w; w.x = cvt_pk_bf16(v0[0], v0[1]); w.y = cvt_pk_bf16(v0[2], v0[3]); w.z = cvt_pk_bf16(v1[0], v1[1]); w.w = cvt_pk_bf16(v1[2], v1[3]);
                    *(u32x4*)(hbp + (size_t)rl * 64 + (size_t)bj * (2 * KT)) = w;
                }
                s = quarter_sum(s);
                if (fq == 0) P[wc * 256 + rl] = s;
            }
            asm volatile("" ::: "memory");
        }
        asm volatile("s_waitcnt lgkmcnt(0)" ::: "memory"); __builtin_amdgcn_s_barrier(); asm volatile("" ::: "memory");
        const int tid = wid * 64 + lane;
        if (tid < 256) { const float s = (P[tid] + P[256 + tid]) + (P[512 + tid] + P[768 + tid]); ssq[(size_t)u.pn * TOK + u.pm * BM + tid] = s; }
    }
};

template <class Epi, int MODE, bool ALIGN_EPI = false, bool SP2 = false>
__device__ __forceinline__ void gemm_phase(PG8_LAS unsigned char* lds, const Gemm g, const StaticOrder& S, const Epi& E, int wave) {
    int tid_ = tid_of(wave); asm volatile("" : "+v"(tid_));
    const int tid = tid_, wid = __builtin_amdgcn_readfirstlane(tid >> 6), lane = tid & 63, wr = wid >> 2, wc = wid & 3, fr = lane & 15, fq = lane >> 4;
    const int K = g.K, nt = K / BK, lda = g.lda;
    unsigned voffA[2], voffB[2];
#pragma unroll
    for (int i = 0; i < 2; ++i) { int R, C; stage_rc(tid * 16 + i * 8192, R, C); const int Rb = Epi::PERM ? ((R & ~31) + perm32(R & 31)) : R;
        voffA[i] = (unsigned)(R * lda + C) * 2u; voffB[i] = (unsigned)(Rb * K + C) * 2u; }
    const size_t kstep = (size_t)(BK * 2);
    const size_t hstepA = (size_t)HALF * lda * 2, hstepB = (size_t)HALF * K * 2;
    const unsigned ldsw = (unsigned)wid * 1024u;
    const int aoff = lds_byte(wr * 64 + fr, fq * 8), boff = lds_byte(wc * 32 + fr, fq * 8);
#define PG8_SA(b, h) (((b) * 2 + (h)) * HTB)
#define PG8_SB(b, h) ((4 + (b) * 2 + (h)) * HTB)
#define PG8_STAGE(bufoff, gbase, voff) do { _Pragma("unroll") for (int _i = 0; _i < 2; ++_i) \
        __builtin_amdgcn_global_load_lds((const unsigned*)((const char*)(gbase) + (voff)[_i]), (PG8_LAS unsigned*)(lds + (bufoff) + ldsw + _i * 8192), 16, 0, 0); } while (0)
#define PG8_LDA(dst, b, h) do { _Pragma("unroll") for (int m = 0; m < 4; ++m) _Pragma("unroll") for (int k = 0; k < 2; ++k) dst[m][k] = *(const PG8_LAS bf16x8*)(lds + PG8_SA(b, h) + aoff + m * 2048 + k * 1024); } while (0)
#define PG8_LDB(dst, b, h) do { _Pragma("unroll") for (int n = 0; n < 2; ++n) _Pragma("unroll") for (int k = 0; k < 2; ++k) dst[n][k] = *(const PG8_LAS bf16x8*)(lds + PG8_SB(b, h) + boff + n * 2048 + k * 1024); } while (0)
#define PG8_MMA(ai, bj, At, Bt) do { __builtin_amdgcn_s_setprio(1); _Pragma("unroll") for (int m = 0; m < 4; ++m) _Pragma("unroll") for (int n = 0; n < 2; ++n) _Pragma("unroll") for (int k = 0; k < 2; ++k) \
        acc[ai][bj][m][n] = __builtin_amdgcn_mfma_f32_16x16x32_bf16(Bt[n][k], At[m][k], acc[ai][bj][m][n], 0, 0, 0); __builtin_amdgcn_s_setprio(0); } while (0)
#define PG8_WAIT_V(n) asm volatile("s_waitcnt vmcnt(" #n ")" ::: "memory")
#define PG8_WAIT_L(n) asm volatile("s_waitcnt lgkmcnt(" #n ")" ::: "memory")
#define PG8_BAR __builtin_amdgcn_s_barrier()
#define PG8_SCHED __builtin_amdgcn_sched_barrier(0)
    Unit cur, nxt; int ui = 0;
    if (!S.next(0, cur)) return;
    f32x4 acc[2][2][4][2];
#pragma unroll
    for (int a = 0; a < 2; ++a)
#pragma unroll
        for (int b = 0; b < 2; ++b)
#pragma unroll
            for (int m = 0; m < 4; ++m)
#pragma unroll
                for (int n = 0; n < 2; ++n) acc[a][b][m][n] = (f32x4){0.f, 0.f, 0.f, 0.f};
    bf16x8 At[4][2], B0[2][2], B1[2][2];
    const char* cA = a_base<MODE>(g, cur); const char* cB = (const char*)g.Bt + (size_t)cur.pn * 2 * hstepB;
    const size_t ko1 = koff<MODE>(g, 1);
    const PG8_LAS float* rstdL = (const PG8_LAS float*)(lds + RSTD_LDS_OFF);
    float my_rstd = 0.f;
    if constexpr (Epi::NEED_RSTD) { if (tid < BM) my_rstd = rstd_of(E.ssq, cur.pm * BM + tid); }
    if constexpr (SP2) {
        PG8_STAGE(PG8_SB(0, 0), cB, voffB); PG8_STAGE(PG8_SB(0, 1), cB + hstepB, voffB); PG8_STAGE(PG8_SA(0, 0), cA, voffA); PG8_STAGE(PG8_SA(0, 1), cA + hstepA, voffA);
        if (wr == 1) PG8_BAR;
        PG8_WAIT_V(2); PG8_BAR;
        PG8_STAGE(PG8_SB(1, 0), cB + kstep, voffB); PG8_STAGE(PG8_SA(1, 0), cA + ko1, voffA); PG8_STAGE(PG8_SB(1, 1), cB + hstepB + kstep, voffB);
        PG8_WAIT_V(6); PG8_BAR;
    } else {
        PG8_STAGE(PG8_SB(0, 0), cB, voffB); PG8_STAGE(PG8_SA(0, 0), cA, voffA); PG8_STAGE(PG8_SB(0, 1), cB + hstepB, voffB); PG8_STAGE(PG8_SA(0, 1), cA + hstepA, voffA);
        if (wr == 1) PG8_BAR;
        PG8_WAIT_V(4); PG8_BAR;
        PG8_STAGE(PG8_SB(1, 0), cB + kstep, voffB); PG8_STAGE(PG8_SA(1, 0), cA + ko1, voffA); PG8_STAGE(PG8_SB(1, 1), cB + hstepB + kstep, voffB);
        PG8_WAIT_V(6); PG8_BAR;
    }
    if constexpr (Epi::NEED_RSTD) { if (tid < BM) ((PG8_LAS float*)(lds + RSTD_LDS_OFF))[tid] = my_rstd; }
    for (;;) {
        const bool has_next = S.next(ui + 1, nxt);
        const char* nA = has_next ? a_base<MODE>(g, nxt) : cA; const char* nB = has_next ? (const char*)g.Bt + (size_t)nxt.pn * 2 * hstepB : cB;
        for (int t = 0; t < nt; t += 2) {
            const bool last = (t == nt - 2);
            const char* a1 = cA + koff<MODE>(g, t + 1);
            const char* a2 = last ? nA : cA + koff<MODE>(g, t + 2); const char* b2 = last ? nB : cB + (size_t)(t + 2) * kstep;
            const char* a3 = last ? nA + ko1 : cA + koff<MODE>(g, t + 3); const char* b3 = b2 + kstep;
            if constexpr (SP2) {
            PG8_LDB(B0, 0, 0); PG8_LDB(B1, 0, 1); PG8_SCHED; PG8_LDA(At, 0, 0); PG8_STAGE(PG8_SA(1, 1), a1 + hstepA, voffA);
            PG8_WAIT_V(8); PG8_WAIT_L(0); PG8_BAR; PG8_MMA(0, 0, At, B0); PG8_MMA(0, 1, At, B1); PG8_BAR; PG8_SCHED;
            PG8_LDA(At, 0, 1); PG8_STAGE(PG8_SB(0, 0), b2, voffB); PG8_STAGE(PG8_SB(0, 1), b2 + hstepB, voffB); PG8_STAGE(PG8_SA(0, 0), a2, voffA);
            PG8_WAIT_V(8); PG8_WAIT_L(0); PG8_BAR; PG8_MMA(1, 0, At, B0); PG8_MMA(1, 1, At, B1); PG8_BAR; PG8_SCHED;
            PG8_LDB(B0, 1, 0); PG8_LDB(B1, 1, 1); PG8_SCHED; PG8_LDA(At, 1, 0); PG8_STAGE(PG8_SA(0, 1), a2 + hstepA, voffA);
            PG8_WAIT_V(8); PG8_WAIT_L(0); PG8_BAR; PG8_MMA(0, 0, At, B0); PG8_MMA(0, 1, At, B1); PG8_BAR; PG8_SCHED;
            PG8_LDA(At, 1, 1); PG8_STAGE(PG8_SB(1, 0), b3, voffB); PG8_STAGE(PG8_SB(1, 1), b3 + hstepB, voffB); PG8_STAGE(PG8_SA(1, 0), a3, voffA);
            PG8_WAIT_V(8); PG8_WAIT_L(0); PG8_BAR; PG8_MMA(1, 0, At, B0); PG8_MMA(1, 1, At, B1); PG8_BAR; PG8_SCHED;
            } else {
            PG8_LDB(B0, 0, 0); PG8_SCHED; PG8_LDA(At, 0, 0); PG8_STAGE(PG8_SA(1, 1), a1 + hstepA, voffA);
            PG8_WAIT_L(8); PG8_BAR; PG8_WAIT_L(0); PG8_MMA(0, 0, At, B0); PG8_BAR; PG8_SCHED;
            PG8_LDB(B1, 0, 1); PG8_STAGE(PG8_SB(0, 0), b2, voffB);
            PG8_BAR; PG8_WAIT_L(0); PG8_MMA(0, 1, At, B1); PG8_BAR;
            PG8_LDA(At, 0, 1); PG8_STAGE(PG8_SA(0, 0), a2, voffA);
            PG8_BAR; PG8_WAIT_L(0); PG8_MMA(1, 0, At, B0); PG8_BAR; PG8_SCHED;
            PG8_STAGE(PG8_SB(0, 1), b2 + hstepB, voffB);
            PG8_WAIT_V(6); PG8_BAR; PG8_MMA(1, 1, At, B1); PG8_BAR;
            PG8_LDB(B0, 1, 0); PG8_SCHED; PG8_LDA(At, 1, 0); PG8_STAGE(PG8_SA(0, 1), a2 + hstepA, voffA);
            PG8_WAIT_L(8); PG8_BAR; PG8_WAIT_L(0); PG8_MMA(0, 0, At, B0); PG8_BAR; PG8_SCHED;
            PG8_LDB(B1, 1, 1); PG8_STAGE(PG8_SB(1, 0), b3, voffB);
            PG8_BAR; PG8_WAIT_L(0); PG8_MMA(0, 1, At, B1); PG8_BAR;
            PG8_LDA(At, 1, 1); PG8_STAGE(PG8_SA(1, 0), a3, voffA);
            PG8_BAR; PG8_WAIT_L(0); PG8_MMA(1, 0, At, B0); PG8_BAR; PG8_SCHED;
            PG8_STAGE(PG8_SB(1, 1), b3 + hstepB, voffB);
            PG8_WAIT_V(6); PG8_BAR; PG8_MMA(1, 1, At, B1); PG8_BAR;
            }
        }
        if constexpr (ALIGN_EPI) { if (wr == 0) PG8_BAR; }
        if constexpr (!Epi::AFTER_DRAIN) { E(acc, cur, wr, wc, fr, fq, rstdL); }
        if (!has_next) break;
#pragma unroll
        for (int a = 0; a < 2; ++a)
#pragma unroll
            for (int b = 0; b < 2; ++b)
#pragma unroll
                for (int m = 0; m < 4; ++m)
#pragma unroll
                    for (int n = 0; n < 2; ++n) acc[a][b][m][n] = (f32x4){0.f, 0.f, 0.f, 0.f};
        cur = nxt; cA = nA; cB = nB; ++ui;
        if constexpr (ALIGN_EPI) { if (wr == 1) PG8_BAR; }
    }
    u32x4 pre[4][2];
    if constexpr (Epi::AFTER_DRAIN) E.prefetch(pre, cur, wr, wc, fr, fq);
    PG8_WAIT_V(0);
    if constexpr (!ALIGN_EPI) { if (wr == 0) PG8_BAR; }
    PG8_BAR;
    if constexpr (Epi::AFTER_DRAIN) { E.fused(acc, pre, cur, wr, wc, fr, fq, lds, wid, lane); }
#undef PG8_SA
#undef PG8_SB
#undef PG8_STAGE
#undef PG8_LDA
#undef PG8_LDB
#undef PG8_MMA
#undef PG8_WAIT_V
#undef PG8_WAIT_L
#undef PG8_BAR
#undef PG8_SCHED
}
}
namespace att {
using bf16x8 = __attribute__((ext_vector_type(8))) short;
using s16x4 = __attribute__((ext_vector_type(4))) short;
using f32x16 = __attribute__((ext_vector_type(16))) float;
using f32x4 = __attribute__((ext_vector_type(4))) float;
using u32x4 = __attribute__((ext_vector_type(4))) unsigned;
typedef unsigned short bf16_t;
#define ATT_LAS __attribute__((address_space(3)))
constexpr int DM = 1024, SEQ = 2048, D = 64, NW = 8, QBLK = 32, QB = 256, KVBLK = 64;
constexpr int NSLOT = 3, SLOTB = 8192;
constexpr int L_K = 0, L_V = NSLOT * SLOTB, L_WS = 2 * NSLOT * SLOTB, L_OST = L_WS + NW * 256, L_TAB = L_OST + NW * 4096, L_QN = L_TAB + 4 * 324 * 4 + 64  , L_END = L_QN + NW * 4096;
constexpr int TABN = 320;
constexpr int TABR = 324;
constexpr float THR = 8.0f;
__device__ __forceinline__ int crow(int r, int hi) { return (r & 3) + 8 * (r >> 2) + 4 * hi; }
#define ASBAR() __builtin_amdgcn_sched_barrier(0)
__device__ __forceinline__ void glds16(const void* gsrc, unsigned lds_dst) { unsigned keep;
    asm volatile("s_mov_b32 %0, m0\n\ts_mov_b32 m0, %2\n\ts_nop 0\n\tglobal_load_lds_dwordx4 %1, off\n\ts_mov_b32 m0, %0" : "=&s"(keep) : "v"(gsrc), "s"(lds_dst) : "memory"); }
__device__ __forceinline__ unsigned cvtpk(float lo, float hi) { unsigned r; asm volatile("v_cvt_pk_bf16_f32 %0, %1, %2" : "=v"(r) : "v"(lo), "v"(hi)); return r; }
#define ATT_WAIT_BAR(N) asm volatile("s_waitcnt vmcnt(" #N ") lgkmcnt(0)\n\ts_barrier" ::: "memory")

__device__ __forceinline__ void vread16(s16x4* lo, s16x4* hi, int vb) {
#pragma unroll
    for (int d0 = 0; d0 < 2; ++d0)
#pragma unroll
        for (int ks = 0; ks < 4; ++ks) {
            asm volatile("ds_read_b64_tr_b16 %0,%1 offset:%c2" : "=&v"(lo[4 * d0 + ks]) : "v"(vb), "i"(d0 * 4096 + ks * 1024) : "memory");
            asm volatile("ds_read_b64_tr_b16 %0,%1 offset:%c2" : "=&v"(hi[4 * d0 + ks]) : "v"(vb), "i"(d0 * 4096 + ks * 1024 + 512) : "memory"); }
}
__device__ __forceinline__ void pv16(f32x16* o, const s16x4* lo, const s16x4* hi, bf16x8 pa0, bf16x8 pa1, bf16x8 pa2, bf16x8 pa3) {
#define ATT_PK(k) (bf16x8){lo[k][0], lo[k][1], lo[k][2], lo[k][3], hi[k][0], hi[k][1], hi[k][2], hi[k][3]}
    o[0] = __builtin_amdgcn_mfma_f32_32x32x16_bf16(pa0, ATT_PK(0), o[0], 0, 0, 0); o[1] = __builtin_amdgcn_mfma_f32_32x32x16_bf16(pa0, ATT_PK(4), o[1], 0, 0, 0);
    o[0] = __builtin_amdgcn_mfma_f32_32x32x16_bf16(pa1, ATT_PK(1), o[0], 0, 0, 0); o[1] = __builtin_amdgcn_mfma_f32_32x32x16_bf16(pa1, ATT_PK(5), o[1], 0, 0, 0);
    o[0] = __builtin_amdgcn_mfma_f32_32x32x16_bf16(pa2, ATT_PK(2), o[0], 0, 0, 0); o[1] = __builtin_amdgcn_mfma_f32_32x32x16_bf16(pa2, ATT_PK(6), o[1], 0, 0, 0);
    o[0] = __builtin_amdgcn_mfma_f32_32x32x16_bf16(pa3, ATT_PK(3), o[0], 0, 0, 0); o[1] = __builtin_amdgcn_mfma_f32_32x32x16_bf16(pa3, ATT_PK(7), o[1], 0, 0, 0);
#undef ATT_PK
}
__device__ __forceinline__ float rowmax32(const f32x16& p0, const f32x16& p1) {
    float a = fmaxf(p0[0], p1[0]);
#pragma unroll
    for (int r = 1; r < 16; ++r) a = fmaxf(a, fmaxf(p0[r], p1[r]));
    auto rr = __builtin_amdgcn_permlane32_swap(__float_as_uint(a), __float_as_uint(a), false, false);
    return fmaxf(__uint_as_float(rr[0]), __uint_as_float(rr[1]));
}

__device__ __forceinline__ void attn_table(const float* tab, ATT_LAS unsigned char* shm, int wave) {
    const int tid = pg8::tid_of(wave); ATT_LAS float* tabL = (ATT_LAS float*)(shm + L_TAB);
    for (int idx = tid; idx < 4 * TABR; idx += NW * 64) { const int s_ = idx / TABR, k_ = idx % TABR - s_; tabL[idx] = (k_ >= 0 && k_ < TABN) ? tab[TABN - 1 - k_] : 0.f; }
}
__device__ __forceinline__ void attn_stream(int b, int h, int qb0, unsigned char* big, const float* tab, ATT_LAS unsigned char* shm, int wave) {
    int tid_ = pg8::tid_of(wave); asm volatile("" : "+v"(tid_));
    const int tid = tid_, lane = tid & 63, r32 = lane & 31, hi = lane >> 5; const int wid = __builtin_amdgcn_readfirstlane(tid >> 6);
    const int ci = wid >> 1;
    ATT_LAS float* tabL = (ATT_LAS float*)(shm + L_TAB);
    ATT_LAS float* wsf = (ATT_LAS float*)(shm + L_WS) + wid * 64;
    const long koffl = (long)h * pg8::KT + (long)lane * D + wid * 8, voffl = (long)h * pg8::KT + (long)(16 * (wid & 3) + (lane >> 2)) * D + (wid >> 2) * 32 + (lane & 3) * 8;
    const unsigned lds0 = (unsigned)(uintptr_t)shm;
    const unsigned kdst = lds0 + L_K + wid * 1024, vdst = lds0 + L_V + wid * 1024;
#define ATT_DMA_C(c_, slotoff) do { const unsigned char* pan_ = big + (size_t)(b * 8 + ((c_) >> 2)) * pg8::PANEL_BYTES; const long ro_ = (long)(((c_) & 3) * KVBLK) * D; \
        glds16((const bf16_t*)(pan_ + pg8::PO_K) + ro_ + koffl, (unsigned)__builtin_amdgcn_readfirstlane(kdst + (slotoff))); \
        glds16((const bf16_t*)(pan_ + pg8::PO_V) + ro_ + voffl, (unsigned)__builtin_amdgcn_readfirstlane(vdst + (slotoff))); } while (0)
#define ATT_CS(qb_) ((4 * (qb_) - 8) > 0 ? (4 * (qb_) - 8) : 0)
#define ATT_LOADQ(qb_) do { const bf16_t* qp_ = (const bf16_t*)(big + (size_t)(b * 8 + (qb_)) * pg8::PANEL_BYTES + pg8::PO_Q) + (long)h * pg8::KT + (long)(wid * QBLK) * D + lane * 8; \
        _Pragma("unroll") for (int i_ = 0; i_ < 4; ++i_) glds16(qp_ + i_ * 512, (unsigned)__builtin_amdgcn_readfirstlane(lds0 + L_QN + wid * 4096 + i_ * 1024)); } while (0)
    const int vb0 = (int)(lds0 + L_V) + ((lane >> 4) & 1) * 32 + (lane & 3) * 8 + (4 * hi + ((lane & 15) >> 2)) * 64;
    const int qi = (wid & 1) * 32 + r32;
    const int sj = (qi + 1) & 3, jb = 191 - qi + 4 * hi + sj;
    const float cfar = tab[TABN - 1];
    int Gtot = 0;
#pragma unroll
    for (int u = 0; u < 4; ++u) { const int qb_ = qb0 + 2 * u; Gtot += 4 * qb_ + 4 - ATT_CS(qb_); }
    bf16x8 qr[4];
#pragma unroll
    for (int d0 = 0; d0 < 4; ++d0) qr[d0] = bf16x8{};
    ATT_LOADQ(qb0);
    int dqb = qb0, dt = 0, dnt = 4 * qb0 + 4 - ATT_CS(qb0);
#define ATT_DMA_NEXT(slotoff) do { ATT_DMA_C(ATT_CS(dqb) + dt, slotoff); if (++dt == dnt) { dqb += 2; dt = 0; dnt = 4 * dqb + 4 - ATT_CS(dqb); } } while (0)
    ATT_DMA_NEXT(0); ATT_DMA_NEXT(SLOTB);
    int qb = qb0, t = 0, cs = ATT_CS(qb0), NT = 4 * qb0 + 4 - cs, cq = 4 * qb + ci, t_lo = ((cq - 8) > 0 ? (cq - 8) : 0) - cs, t_hi = cq - cs;
    float mhat = 0.f, l_reg = 0.f; f32x16 o[2]; o[0] = f32x16{}; o[1] = f32x16{};
    bool need_q = false, qwait = false;
    int slot = 0;
    for (int g = 0; g < Gtot; ++g) {
        if (g + 1 < Gtot) { if (qwait) { ATT_WAIT_BAR(6); } else { ATT_WAIT_BAR(2); } } else { ATT_WAIT_BAR(0); }
        qwait = false;
        if (g + 2 < Gtot) { const int s2 = (slot >= SLOTB) ? slot - SLOTB : slot + 2 * SLOTB; ATT_DMA_NEXT(s2); }
        if (need_q) { need_q = false; qwait = true; ATT_LOADQ(qb + ((t > t_hi) ? 2 : 0)); }
        if (t >= t_lo && t <= t_hi) {
            const int dc = t_hi - t;
            s16x4 vlo[8], vhi[8];
            vread16(vlo, vhi, vb0 + slot);
            bf16x8 kf[8];
            { const ATT_LAS unsigned char* kb = shm + L_K + slot + hi * 1024 + r32 * 16;
#pragma unroll
              for (int d0 = 0; d0 < 4; ++d0) { kf[2 * d0] = *reinterpret_cast<const ATT_LAS bf16x8*>(kb + d0 * 2048); kf[2 * d0 + 1] = *reinterpret_cast<const ATT_LAS bf16x8*>(kb + d0 * 2048 + 512); } }
            if (t == t_lo) { mhat = 0.f; l_reg = 0.f; o[0] = f32x16{}; o[1] = f32x16{};
                const ATT_LAS unsigned char* qn = shm + L_QN + wid * 4096 + r32 * 128 + hi * 16;
#pragma unroll
                for (int d0 = 0; d0 < 4; ++d0) qr[d0] = *reinterpret_cast<const ATT_LAS bf16x8*>(qn + d0 * 32); }
            f32x16 p0, p1;
            if (dc >= 3) {
                asm volatile("s_waitcnt lgkmcnt(0)" ::: "memory"); ASBAR();
#pragma unroll
                for (int r = 0; r < 16; ++r) { p0[r] = cfar - mhat; p1[r] = cfar - mhat; }
#pragma unroll
                for (int d0 = 0; d0 < 4; ++d0) { p0 = __builtin_amdgcn_mfma_f32_32x32x16_bf16(kf[2 * d0], qr[d0], p0, 0, 0, 0); p1 = __builtin_amdgcn_mfma_f32_32x32x16_bf16(kf[2 * d0 + 1], qr[d0], p1, 0, 0, 0); }
            } else {
                const ATT_LAS float* tb = tabL + sj * TABR + (jb - 64 * dc);
                f32x4 b0[4], b1[4];
#pragma unroll
                for (int g4 = 0; g4 < 4; ++g4) { b0[g4] = *(const ATT_LAS f32x4*)(tb + 8 * g4); b1[g4] = *(const ATT_LAS f32x4*)(tb + 32 + 8 * g4); }
                asm volatile("s_waitcnt lgkmcnt(0)" ::: "memory"); ASBAR();
#pragma unroll
                for (int r = 0; r < 16; ++r) { p0[r] = b0[r >> 2][r & 3] - mhat; p1[r] = b1[r >> 2][r & 3] - mhat; }
#pragma unroll
                for (int d0 = 0; d0 < 4; ++d0) { p0 = __builtin_amdgcn_mfma_f32_32x32x16_bf16(kf[2 * d0], qr[d0], p0, 0, 0, 0); p1 = __builtin_amdgcn_mfma_f32_32x32x16_bf16(kf[2 * d0 + 1], qr[d0], p1, 0, 0, 0); }
            }
            const float rm = rowmax32(p0, p1);
            if (t == t_lo) {
                mhat = rm;
#pragma unroll
                for (int r = 0; r < 16; ++r) { p0[r] -= rm; p1[r] -= rm; }
            } else if (__any(rm > THR)) {
                const float dl = fmaxf(rm, 0.f); mhat += dl;
#pragma unroll
                for (int r = 0; r < 16; ++r) { p0[r] -= dl; p1[r] -= dl; }
                const float f = __builtin_amdgcn_exp2f(-dl); l_reg *= f;
                if (hi == 0) wsf[r32] = f;
                asm volatile("s_waitcnt lgkmcnt(0)" ::: "memory");
#pragma unroll
                for (int g4 = 0; g4 < 4; ++g4) { const f32x4 fv = *(const ATT_LAS f32x4*)(wsf + 8 * g4 + 4 * hi);
#pragma unroll
                    for (int i = 0; i < 4; ++i) { o[0][4 * g4 + i] *= fv[i]; o[1][4 * g4 + i] *= fv[i]; } }
            }
            float sacc = 0.f;
#pragma unroll
            for (int r = 0; r < 16; ++r) { p0[r] = __builtin_amdgcn_exp2f(p0[r]); p1[r] = __builtin_amdgcn_exp2f(p1[r]); sacc += p0[r] + p1[r]; }
            l_reg += sacc;
            u32x4 pw0, pw1, pw2, pw3;
            pw0 = (u32x4){cvtpk(p0[0], p0[1]), cvtpk(p0[2], p0[3]), cvtpk(p0[4], p0[5]), cvtpk(p0[6], p0[7])};
            pw1 = (u32x4){cvtpk(p0[8], p0[9]), cvtpk(p0[10], p0[11]), cvtpk(p0[12], p0[13]), cvtpk(p0[14], p0[15])};
            pw2 = (u32x4){cvtpk(p1[0], p1[1]), cvtpk(p1[2], p1[3]), cvtpk(p1[4], p1[5]), cvtpk(p1[6], p1[7])};
            pw3 = (u32x4){cvtpk(p1[8], p1[9]), cvtpk(p1[10], p1[11]), cvtpk(p1[12], p1[13]), cvtpk(p1[14], p1[15])};
            ASBAR();
            pv16(o, vlo, vhi, __builtin_bit_cast(bf16x8, pw0), __builtin_bit_cast(bf16x8, pw1), __builtin_bit_cast(bf16x8, pw2), __builtin_bit_cast(bf16x8, pw3));
            if (t == t_hi) {
                { auto rr = __builtin_amdgcn_permlane32_swap(__float_as_uint(l_reg), __float_as_uint(l_reg), false, false); l_reg = __uint_as_float(rr[0]) + __uint_as_float(rr[1]); }
                if (hi == 0) wsf[32 + r32] = l_reg;
                asm volatile("s_waitcnt lgkmcnt(0)" ::: "memory");
                float rli[16];
#pragma unroll
                for (int g4 = 0; g4 < 4; ++g4) { const f32x4 lv = *(const ATT_LAS f32x4*)(wsf + 32 + 8 * g4 + 4 * hi);
#pragma unroll
                    for (int i = 0; i < 4; ++i) rli[4 * g4 + i] = __builtin_amdgcn_rcpf(lv[i]); }
                bf16_t* Ow = (bf16_t*)(big + (size_t)(b * 8 + qb) * pg8::PANEL_BYTES + pg8::PO_O) + (long)h * pg8::KT + (long)(wid * QBLK) * D;
                ATT_LAS bf16_t* stg = (ATT_LAS bf16_t*)(shm + L_OST) + wid * 2048;
#pragma unroll
                for (int r = 0; r < 16; ++r) { const int orow = crow(r, hi);
#pragma unroll
                    for (int d0 = 0; d0 < 2; ++d0) { const float v = o[d0][r] * rli[r]; const unsigned pk = cvtpk(v, v); stg[orow * 64 + d0 * 32 + r32] = (bf16_t)(pk & 0xffffu); } }
                asm volatile("s_waitcnt lgkmcnt(0)" ::: "memory");
#pragma unroll
                for (int i = 0; i < 4; ++i) { const int row = i * 8 + (lane >> 3), ch = lane & 7; const u32x4 v = *(const ATT_LAS u32x4*)(stg + row * 64 + ch * 8); *(u32x4*)(Ow + (long)row * D + ch * 8) = v; }
                need_q = (qb + 2 < qb0 + 8);
            }
        }
        slot = (slot == 2 * SLOTB) ? 0 : slot + SLOTB;
        if (++t == NT) { qb += 2; t = 0; cs = ATT_CS(qb); NT = 4 * qb + 4 - cs; cq = 4 * qb + ci; t_lo = ((cq - 8) > 0 ? (cq - 8) : 0) - cs; t_hi = cq - cs; }
    }
    asm volatile("s_waitcnt lgkmcnt(0)\n\ts_barrier" ::: "memory");
#undef ATT_DMA_C
#undef ATT_CS
#undef ATT_LOADQ
#undef ATT_DMA_NEXT
}
#undef ASBAR
}
constexpr int NWAVES = 8;
constexpr int BATCH = 8, SEQ = 2048, DM = 1024, NH = 16, FF = 4096, TOK = BATCH * SEQ, DEPTH = 4;
constexpr size_t MiB = 1u << 20;
constexpr size_t WS_CTL = 0, CTL_ZERO_BYTES = 1 * MiB;
constexpr size_t WS_TEXT = 1 * MiB;
constexpr size_t WS_GC = 1 * MiB + 64 * 1024;
constexpr size_t WS_SSQ = 1 * MiB + 256 * 1024;
constexpr size_t WS_ARENA = 2 * MiB, ARENA_BYTES = 24 * MiB;
constexpr size_t AR_MIX = 0, AR_WO = 6 * MiB, AR_WG = 4 * MiB, AR_W1 = 8 * MiB, AR_W2 = 16 * MiB;
constexpr size_t WS_HB = 50 * MiB;
constexpr size_t WS_BIG = 82 * MiB;
constexpr size_t WS_END = WS_BIG + 64 * pg8::PANEL_BYTES;
static_assert(WS_END <= 256 * MiB, "d_ws map");
constexpr int CW_BAR = 4096;

constexpr int RING_OFF = 0, RING_BYTES = 131072;
constexpr int LDSCTL_OFF = RING_BYTES, MISC_OFF = LDSCTL_OFF + 320;
constexpr int LDS_BYTES = 147456;
static_assert(att::L_END <= RING_BYTES, "attention scratch fits the ring region");

#define GAS __attribute__((address_space(1)))
#define LAS __attribute__((address_space(3)))
typedef unsigned short bf16;
typedef unsigned v4u __attribute__((ext_vector_type(4)));
typedef float f32x4 __attribute__((ext_vector_type(4)));
typedef GAS unsigned gu32;
#define RLX_AGENT __ATOMIC_RELAXED, __HIP_MEMORY_SCOPE_AGENT
#define LDS_WAIT() asm volatile("s_waitcnt lgkmcnt(0)" ::: "memory")
#define VM_WAIT() asm volatile("s_waitcnt vmcnt(0)" ::: "memory")
__device__ __forceinline__ unsigned f2bf(float f) { unsigned u = __builtin_bit_cast(unsigned, f); return (u + 0x7fffu + ((u >> 16) & 1u)) >> 16; }
__device__ __forceinline__ unsigned pk2(float lo, float hi) { return f2bf(lo) | (f2bf(hi) << 16); }

#define XB_TMO      128
#define XB_XCNT(j)  (256  + 64 * (j))
#define XB_XSUB(j)  (1280 + 64 * (j))
#define XB_XGEN(j)  (2304 + 64 * (j))
#define XB_TOP      3328
#define XB_TOPGEN   3392
#define XCD_BAR_WORDS 3456
#define XB_SPIN_CAP (1u << 18)
__device__ __forceinline__ unsigned xb_ld(unsigned* p)              { return __hip_atomic_load(p, __ATOMIC_RELAXED, __HIP_MEMORY_SCOPE_AGENT); }
__device__ __forceinline__ unsigned xb_add(unsigned* p, unsigned v) { return __hip_atomic_fetch_add(p, v, __ATOMIC_RELAXED, __HIP_MEMORY_SCOPE_AGENT); }
__device__ __forceinline__ unsigned xb_xcc_id() { return (unsigned)__builtin_amdgcn_s_getreg((3 << 11) | 20) & 0xFu; }
#define XB_SPIN(cond, bar) do { unsigned _sp = 0; while (cond) { __builtin_amdgcn_s_sleep(1); \
    if ((++_sp & 255u) == 0u) { if (xb_ld(&(bar)[XB_TMO])) break; if (_sp > XB_SPIN_CAP) { atomicAdd(&(bar)[XB_TMO], 1u); break; } } } } while (0)
struct XcdBarrier { unsigned* bar; unsigned x; volatile LAS unsigned* st; };
__device__ __forceinline__ XcdBarrier xcd_barrier_post(unsigned* bar, volatile LAS unsigned* st) {
    XcdBarrier b; b.bar = bar; b.x = xb_xcc_id(); b.st = st;
    if (threadIdx.x == 0) (void)xb_add(&bar[XB_XCNT(b.x)], 1u);
    return b;
}
__device__ __forceinline__ void xcd_barrier_complete(unsigned* bar, unsigned x, unsigned& nloc, unsigned& nx) {
    const unsigned G = gridDim.x * gridDim.y * gridDim.z;
    unsigned sum, cnt, mine, sp = 0u;
    for (;;) {
        sum = 0u; cnt = 0u; mine = 0u;
#pragma unroll
        for (unsigned j = 0; j < 16; ++j) { const unsigned c = xb_ld(&bar[XB_XCNT(j)]); sum += c; cnt += (c > 0u) ? 1u : 0u; mine = (j == x) ? c : mine; }
        if (sum == G) break;
        __builtin_amdgcn_s_sleep(1);
        if ((++sp & 255u) == 0u) { if (xb_ld(&bar[XB_TMO])) break; if (sp > XB_SPIN_CAP) { atomicAdd(&bar[XB_TMO], 1u); break; } }
    }
    nloc = mine > 0u ? mine : 1u; nx = cnt > 0u ? cnt : 1u;
}
__device__ __forceinline__ void xcd_barrier(const XcdBarrier& b, int wave) {
    asm volatile("s_waitcnt vmcnt(0)" ::: "memory");
    __syncthreads();
    if (pg8::tid_of(wave) == 0) {
        unsigned* bar = b.bar;
        __builtin_amdgcn_s_waitcnt(0);
        unsigned nloc = b.st[0], nx = b.st[1];
        if (nloc == 0u) { xcd_barrier_complete(bar, b.x, nloc, nx); b.st[0] = nloc; b.st[1] = nx; }
        const unsigned old = xb_add(&bar[XB_XSUB(b.x)], 1u);
        const unsigned gen = old / nloc;
        if (old + 1u == (gen + 1u) * nloc) {
            __builtin_amdgcn_fence(__ATOMIC_RELEASE, "agent");
            asm volatile("s_waitcnt vmcnt(0)" ::: "memory");
            const unsigned og = xb_add(&bar[XB_TOP], 1u);
            const unsigned tg = og / nx;
            if (og + 1u == (tg + 1u) * nx) xb_add(&bar[XB_TOPGEN], 1u);
            else XB_SPIN(xb_ld(&bar[XB_TOPGEN]) == tg, bar);
            __builtin_amdgcn_fence(__ATOMIC_ACQUIRE, "agent");
            xb_add(&bar[XB_XGEN(b.x)], 1u);
            asm volatile("s_waitcnt vmcnt(0)" ::: "memory");
        } else {
            XB_SPIN(xb_ld(&bar[XB_XGEN(b.x)]) == gen, bar);
            __builtin_amdgcn_fence(__ATOMIC_ACQUIRE, "agent");
            asm volatile("s_waitcnt vmcnt(0)" ::: "memory");
        }
    }
    __syncthreads();
}


#define GB_BASE(g)    (8192 + 1024 * (g))
#define GB_CEN(x)     (16 * (x))
#define GB_SUB(x)     (256 + 16 * (x))
#define GB_GEN(x)     (512 + 16 * (x))
#define GB_TOP        768
#define GB_TOPGEN     784
#define GB_SPIN(cond) do { unsigned _sp = 0; while (cond) { __builtin_amdgcn_s_sleep(1); if (++_sp > (1u << 22)) break; } } while (0)
__device__ __forceinline__ void group_barrier_post(unsigned* ctl, unsigned group) {
    if (threadIdx.x == 0) (void)xb_add(&ctl[GB_BASE(group) + GB_CEN(xb_xcc_id())], 1u);
}
__device__ __forceinline__ void group_barrier(unsigned* ctl, unsigned group, volatile LAS unsigned* st, int wave) {
    asm volatile("s_waitcnt vmcnt(0)" ::: "memory");
    __syncthreads();
    if (pg8::tid_of(wave) == 0) {
        unsigned* w = ctl + GB_BASE(group); const unsigned x = xb_xcc_id();
        __builtin_amdgcn_s_waitcnt(0);
        unsigned nloc = st[0], nx = st[1];
        if (nloc == 0u) { nx = 0u;
#pragma unroll
            for (unsigned j = 0; j < 16; ++j) { const unsigned c = xb_ld(&w[GB_CEN(j)]); nx += (c > 0u) ? 1u : 0u; nloc = (j == x) ? c : nloc; }
            nloc = nloc > 0u ? nloc : 1u; nx = nx > 0u ? nx : 1u; st[0] = nloc; st[1] = nx; }
        const unsigned old = xb_add(&w[GB_SUB(x)], 1u);
        const unsigned gen = old / nloc;
        if (old + 1u == (gen + 1u) * nloc) {
            if (nx > 1u) {
                __builtin_amdgcn_fence(__ATOMIC_RELEASE, "agent");
                asm volatile("s_waitcnt vmcnt(0)" ::: "memory");
                const unsigned og = xb_add(&w[GB_TOP], 1u);
                const unsigned tg = og / nx;
                if (og + 1u == (tg + 1u) * nx) xb_add(&w[GB_TOPGEN], 1u);
                else GB_SPIN(xb_ld(&w[GB_TOPGEN]) == tg);
            }
            __builtin_amdgcn_fence(__ATOMIC_ACQUIRE, "agent");
            xb_add(&w[GB_GEN(x)], 1u);
            asm volatile("s_waitcnt vmcnt(0)" ::: "memory");
        } else {
            GB_SPIN(xb_ld(&w[GB_GEN(x)]) == gen);
            __builtin_amdgcn_fence(__ATOMIC_ACQUIRE, "agent");
            asm volatile("s_waitcnt vmcnt(0)" ::: "memory");
        }
    }
    __syncthreads();
}

__device__ __forceinline__ int opq_bx() { int b = blockIdx.x; asm volatile("" : "+s"(b)); return b; }
__device__ __forceinline__ int opq_i(int v) { asm volatile("" : "+s"(v)); return v; }
__device__ __forceinline__ unsigned char* opq_p(unsigned char* p) { unsigned long long a = (unsigned long long)p; asm volatile("" : "+s"(a)); return (unsigned char*)(GAS unsigned char*)a; }
__device__ __forceinline__ int opq_v(int v) { asm volatile("" : "+v"(v)); return v; }
struct Frame {
    LAS unsigned char* lds;
    volatile LAS unsigned* MISC;
    int tid, lane, wave, vcu, G;
    float* out; unsigned char* ws;
};
#define CAS __attribute__((address_space(4)))
__device__ __forceinline__ const float* inp(int i) {
    const CAS char* ka = (const CAS char*)__builtin_amdgcn_kernarg_segment_ptr(); asm volatile("" : "+s"(ka));
    const GAS float* p = *(const GAS float* const CAS*)(ka + 8 * i);
    return (const float*)p;
}
__device__ __forceinline__ float wave_sum(float v) {
    v += __int_as_float(__builtin_amdgcn_ds_swizzle(__float_as_int(v), 0x041F));
    v += __int_as_float(__builtin_amdgcn_ds_swizzle(__float_as_int(v), 0x081F));
    v += __int_as_float(__builtin_amdgcn_ds_swizzle(__float_as_int(v), 0x101F));
    v += __int_as_float(__builtin_amdgcn_ds_swizzle(__float_as_int(v), 0x201F));
    v += __int_as_float(__builtin_amdgcn_ds_swizzle(__float_as_int(v), 0x401F));
    const auto rr = __builtin_amdgcn_permlane32_swap(__float_as_uint(v), __float_as_uint(v), false, false);
    return __uint_as_float(rr[0]) + __uint_as_float(rr[1]);
}
__device__ __forceinline__ void transpose_item(const float* W, int N, bf16* WT, int ldo, const float* scale, LAS float* scr, int item, int nblk, int lane) {
    const int kb = item / nblk, nb = item % nblk, k0 = 64 * kb, n0 = 32 * nb;
    float v[32];
#pragma unroll
    for (int i = 0; i < 32; ++i) v[i] = __builtin_nontemporal_load(W + (size_t)(k0 + 2 * i + (lane >> 5)) * N + n0 + (lane & 31));
    if (scale) {
#pragma unroll
        for (int i = 0; i < 32; ++i) v[i] *= scale[k0 + 2 * i + (lane >> 5)]; }
#pragma unroll
    for (int i = 0; i < 32; ++i) scr[(2 * i + (lane >> 5)) * 33 + (lane & 31)] = v[i];
    LDS_WAIT(); asm volatile("" ::: "memory");
    const int c = lane & 7;
#pragma unroll
    for (int j = 0; j < 4; ++j) { const int n = (lane >> 3) + 8 * j; const LAS float* s = scr + (8 * c) * 33 + n;
        v4u o; o.x = pk2(s[0 * 33], s[1 * 33]); o.y = pk2(s[2 * 33], s[3 * 33]); o.z = pk2(s[4 * 33], s[5 * 33]); o.w = pk2(s[6 * 33], s[7 * 33]);
        *(GAS v4u*)(WT + (size_t)(n0 + n) * ldo + k0 + 8 * c) = o; }
    LDS_WAIT(); asm volatile("" ::: "memory");
}
__device__ __forceinline__ unsigned char* arena_of(Frame& F, int L) { return L < 2 ? (unsigned char*)F.out + (size_t)L * ARENA_BYTES : F.ws + WS_ARENA + (size_t)(L - 2) * ARENA_BYTES; }
constexpr int CI_W1 = (DM / 64) * (FF / 32), CI_W2 = (FF / 64) * (DM / 32);
constexpr int CI_ATT_A = (DM / 64) * (3 * DM / 32), CI_ATT_B = (DM / 64) * (DM / 32), CI_ATT = CI_ATT_A + CI_ATT_B + CI_W1 + CI_W2;
constexpr int CI_REC_A = (DM / 64) * (2 * DM / 32), CI_REC_G = 512, CI_REC_B = (DM / 64) * (DM / 32), CI_REC = CI_REC_A + CI_REC_G + CI_REC_B + CI_W1 + CI_W2;
struct ConvPtrs { const float *nmix, *nmlp, *wqkv, *wo, *win, *cw, *wga, *wgx, *wro, *w1, *w2; };
__device__ __forceinline__ void convert_item(Frame& F, const ConvPtrs& P, int L, int r, LAS float* scr) {
    const int j = L >> 1;
    unsigned char* ar = arena_of(F, L);
    const float* w1 = P.w1 + (size_t)L * DM * FF; const float* w2 = P.w2 + (size_t)L * FF * DM;
    const float* gmix = P.nmix + L * DM; const float* gmlp = P.nmlp + L * DM;
    if ((L & 1) == 0) {
        const float* wqkv = P.wqkv + (size_t)j * DM * 3 * DM; const float* wo = P.wo + (size_t)j * DM * DM;
        if (r < CI_ATT_A) { transpose_item(wqkv, 3 * DM, (bf16*)(ar + AR_MIX), DM, gmix, scr, r, 3 * DM / 32, F.lane); return; } r -= CI_ATT_A;
        if (r < CI_ATT_B) { transpose_item(wo, DM, (bf16*)(ar + AR_WO), DM, nullptr, scr, r, DM / 32, F.lane); return; } r -= CI_ATT_B;
    } else {
        const float* win = P.win + (size_t)j * DM * 2 * DM; const float* wro = P.wro + (size_t)j * DM * DM;
        const float* wga = P.wga + (size_t)j * 8 * 128 * 128; const float* wgx = P.wgx + (size_t)j * 8 * 128 * 128; const float* cw = P.cw + (size_t)j * 4 * DM;
        if (r < CI_REC_A) { transpose_item(win, 2 * DM, (bf16*)(ar + AR_MIX), DM, gmix, scr, r, 2 * DM / 32, F.lane); return; } r -= CI_REC_A;
        if (r < CI_REC_G) { const int sub = r & 7, q = r >> 3, tap = q & 3, gate = (q >> 2) & 1, n = q >> 3;
            transpose_item((gate ? wgx : wga) + (size_t)n * 128 * 128, 128, (bf16*)(ar + AR_WG) + (size_t)(n * 256 + gate * 128) * 512 + tap * 128, 512, cw + tap * DM + n * 128, scr, sub, 4, F.lane); return; } r -= CI_REC_G;
        if (r < CI_REC_B) { transpose_item(wro, DM, (bf16*)(ar + AR_WO), DM, nullptr, scr, r, DM / 32, F.lane); return; } r -= CI_REC_B;
    }
    if (r < CI_W1) { transpose_item(w1, FF, (bf16*)(ar + AR_W1), DM, gmlp, scr, r, FF / 32, F.lane); return; } r -= CI_W1;
    transpose_item(w2, DM, (bf16*)(ar + AR_W2), FF, nullptr, scr, r, DM / 32, F.lane);
}
__device__ __forceinline__ void convert_all(Frame& F) {
    LAS float* scr = (LAS float*)(F.lds + RING_OFF + F.wave * 16384);
    const int gw = F.vcu * NWAVES + F.wave, NGW = F.G * NWAVES;
    const ConvPtrs P{inp(1), inp(2), inp(3), inp(4), inp(6), inp(8), inp(10), inp(12), inp(15), inp(17), inp(18)};
    for (int it = gw; it < 2 * (CI_ATT + CI_REC); it += NGW) {
        const int pair = it / (CI_ATT + CI_REC), r = it % (CI_ATT + CI_REC);
        if (r < CI_ATT) convert_item(F, P, 2 * pair, r, scr); else convert_item(F, P, 2 * pair + 1, r - CI_ATT, scr);
    }
}
__device__ __forceinline__ void p0_prologue(Frame& F) {
    convert_all(F);
    const int gt = F.vcu * (NWAVES * 64) + F.tid;
    if (gt < 2 * NH * 320) {
        const int i = gt % 320, jh = gt / 320; const float* rel = inp(5);
        ((float*)(F.ws + WS_TEXT))[gt] = rel[(size_t)jh * 257 + (i < 256 ? i : 256)] * 1.4426950408889634f;
    } else if (gt >= 16384 && gt < 16384 + 2 * DM) {
        const int q = gt - 16384, j = q >> 10, ch = q & 1023, n = ch >> 7, e = ch & 127;
        const float* cb = inp(9) + j * DM; const float* cw = inp(8) + (size_t)j * 4 * DM;
        const float* wga = inp(10) + ((size_t)j * 8 + n) * 128 * 128; const float* wgx = inp(12) + ((size_t)j * 8 + n) * 128 * 128;
        float sa = inp(11)[j * DM + ch], sx = inp(13)[j * DM + ch];
        for (int c = 0; c < 128; ++c) { const float cv = cb[n * 128 + c]; sa += cv * wga[c * 128 + e]; sx += cv * wgx[c * 128 + e]; }
        const float Lp = inp(14)[j * DM + ch];
        float* g = (float*)(F.ws + WS_GC) + (size_t)q * 8;
        g[0] = sa; g[1] = sx; g[2] = cb[ch]; g[3] = -8.0f * log1pf(expf(-Lp)) * 1.4426950408889634f;
        g[4] = cw[ch]; g[5] = cw[DM + ch]; g[6] = cw[2 * DM + ch]; g[7] = cw[3 * DM + ch];
    }
    const int gw = F.vcu * NWAVES + F.wave, NGW = F.G * NWAVES;
    const float* x = inp(0); bf16* hb = (bf16*)(F.ws + WS_HB); float* ssq = (float*)(F.ws + WS_SSQ);
    for (int m = gw; m < TOK; m += NGW) {
        const GAS f32x4* xr = (const GAS f32x4*)(x + (size_t)m * DM) + F.lane;
        f32x4 v[4]; float s = 0.f;
#pragma unroll
        for (int jj = 0; jj < 4; ++jj) { v[jj] = xr[64 * jj]; s += (v[jj].x * v[jj].x + v[jj].y * v[jj].y) + (v[jj].z * v[jj].z + v[jj].w * v[jj].w); }
        s = wave_sum(s);
        bf16* hp = hb + (size_t)(m >> 8) * (256 * DM) + (size_t)(m & 255) * 64;
#pragma unroll
        for (int jj = 0; jj < 4; ++jj) *(GAS unsigned long long*)(hp + (size_t)((F.lane >> 4) + 4 * jj) * pg8::KT + 4 * (F.lane & 15)) = (unsigned long long)pk2(v[jj].x, v[jj].y) | ((unsigned long long)pk2(v[jj].z, v[jj].w) << 32);
        if (F.lane < 4) ssq[(size_t)F.lane * TOK + m] = (F.lane == 0) ? s : 0.f;
    }
}
__device__ __forceinline__ void final_norm(Frame& F) {
    const int gw = F.vcu * NWAVES + F.wave, NGW = F.G * NWAVES; const float* gf = inp(19); const bf16* hb = (const bf16*)(F.ws + WS_HB);
    f32x4 g[4];
#pragma unroll
    for (int jj = 0; jj < 2; ++jj) { g[2 * jj] = *(const f32x4*)(gf + 512 * jj + 8 * F.lane); g[2 * jj + 1] = *(const f32x4*)(gf + 512 * jj + 8 * F.lane + 4); }
    for (int m = gw; m < TOK; m += NGW) {
        f32x4 v[4]; float s = 0.f;
#pragma unroll
        for (int jj = 0; jj < 2; ++jj) { const v4u r = *(const GAS v4u*)(hb + (size_t)(m >> 8) * (256 * DM) + (size_t)((F.lane >> 3) + 8 * jj) * pg8::KT + (size_t)(m & 255) * 64 + 8 * (F.lane & 7));
            v[2 * jj] = (f32x4){pg8::bf_lo(r.x), pg8::bf_hi(r.x), pg8::bf_lo(r.y), pg8::bf_hi(r.y)}; v[2 * jj + 1] = (f32x4){pg8::bf_lo(r.z), pg8::bf_hi(r.z), pg8::bf_lo(r.w), pg8::bf_hi(r.w)}; }
#pragma unroll
        for (int q = 0; q < 4; ++q) s += (v[q].x * v[q].x + v[q].y * v[q].y) + (v[q].z * v[q].z + v[q].w * v[q].w);
        const float rstd = __builtin_amdgcn_rsqf(wave_sum(s) * (1.0f / DM) + 1e-6f);
#pragma unroll
        for (int jj = 0; jj < 2; ++jj) { GAS f32x4* o = (GAS f32x4*)(F.out + (size_t)m * DM + 512 * jj + 8 * F.lane); o[0] = v[2 * jj] * rstd * g[2 * jj]; o[1] = v[2 * jj + 1] * rstd * g[2 * jj + 1]; }
    }
}
__device__ __forceinline__ void scan_phase(Frame& F, unsigned char* big, const float* gc) {
    LAS float* sA = (LAS float*)(F.lds + RING_OFF);
    LAS float* sH = sA + 1024;
    LAS float* sC = sH + 1024;
    for (int item = opq_i(F.vcu); item < BATCH * 32; item += F.G) {
        const int tid = opq_v(pg8::tid_of(F.wave)); const int b = item >> 5, cg = item & 31, cp = tid & 15, seg = tid >> 4;
        const int ch = cg * 32 + 2 * cp;
        const f32x4 k0a = *(const f32x4*)(gc + (size_t)ch * 8), k0b = *(const f32x4*)(gc + (size_t)ch * 8 + 4), k1a = *(const f32x4*)(gc + (size_t)(ch + 1) * 8), k1b = *(const f32x4*)(gc + (size_t)(ch + 1) * 8 + 4);
        const float cb0 = k0a[2], cb1 = k1a[2];
        if (tid < 32) sC[tid] = 0.f;
#pragma unroll 1
        for (int hf = 0; hf < 2; ++hf) {
            const int t0 = hf * 1024 + seg * 32;
            const unsigned char* pan = big + (size_t)(b * 8 + (t0 >> 8)) * pg8::PANEL_BYTES;
            const size_t eo = (size_t)(ch >> 6) * pg8::KT + (size_t)(t0 & 255) * 64 + (ch & 63), eox = (size_t)(ch >> 6) * pg8::KTX + (size_t)(t0 & 255) * 64 + (ch & 63);
            const unsigned* pa = (const unsigned*)((const bf16*)(pan + pg8::PO_AL) + eo); const unsigned* pb = (const unsigned*)((const bf16*)(pan + pg8::PO_BQ) + eo);
            const unsigned* py = (const unsigned*)((const bf16*)(pan + pg8::PO_Y) + eo); const unsigned* px = (const unsigned*)((const bf16*)(pan + pg8::PO_X) + eox);
            unsigned ua[32], ub[32], uy[32], ux[35];
#pragma unroll
            for (int s = 0; s < 35; ++s) ux[s] = px[(size_t)s * 32];
#pragma unroll
            for (int s = 0; s < 32; ++s) { ua[s] = pa[(size_t)s * 32]; ub[s] = pb[(size_t)s * 32]; }
#pragma unroll
            for (int s = 0; s < 32; ++s) uy[s] = py[(size_t)s * 32];
            float A0 = 1.f, A1 = 1.f, H0 = 0.f, H1 = 0.f;
#pragma unroll
            for (int s = 0; s < 32; ++s) {
                const float a0 = __builtin_amdgcn_exp2f(pg8::bf_lo(ua[s])), a1 = __builtin_amdgcn_exp2f(pg8::bf_hi(ua[s]));
                const float xc0 = cb0 + k0b[0] * pg8::bf_lo(ux[s]) + k0b[1] * pg8::bf_lo(ux[s + 1]) + k0b[2] * pg8::bf_lo(ux[s + 2]) + k0b[3] * pg8::bf_lo(ux[s + 3]);
                const float xc1 = cb1 + k1b[0] * pg8::bf_hi(ux[s]) + k1b[1] * pg8::bf_hi(ux[s + 1]) + k1b[2] * pg8::bf_hi(ux[s + 2]) + k1b[3] * pg8::bf_hi(ux[s + 3]);
                H0 = a0 * H0 + pg8::bf_lo(ub[s]) * xc0; H1 = a1 * H1 + pg8::bf_hi(ub[s]) * xc1; A0 *= a0; A1 *= a1; }
            sA[seg * 32 + 2 * cp] = A0; sA[seg * 32 + 2 * cp + 1] = A1; sH[seg * 32 + 2 * cp] = H0; sH[seg * 32 + 2 * cp + 1] = H1;
            __syncthreads();
            float c0 = sC[2 * cp], c1 = sC[2 * cp + 1];
            for (int s2 = 0; s2 < seg; ++s2) { c0 = sA[s2 * 32 + 2 * cp] * c0 + sH[s2 * 32 + 2 * cp]; c1 = sA[s2 * 32 + 2 * cp + 1] * c1 + sH[s2 * 32 + 2 * cp + 1]; }
            unsigned* po = (unsigned*)((bf16*)(pan + pg8::PO_G) + eo);
#pragma unroll
            for (int s = 0; s < 32; ++s) {
                const float a0 = __builtin_amdgcn_exp2f(pg8::bf_lo(ua[s])), a1 = __builtin_amdgcn_exp2f(pg8::bf_hi(ua[s]));
                const float xc0 = cb0 + k0b[0] * pg8::bf_lo(ux[s]) + k0b[1] * pg8::bf_lo(ux[s + 1]) + k0b[2] * pg8::bf_lo(ux[s + 2]) + k0b[3] * pg8::bf_lo(ux[s + 3]);
                const float xc1 = cb1 + k1b[0] * pg8::bf_hi(ux[s]) + k1b[1] * pg8::bf_hi(ux[s + 1]) + k1b[2] * pg8::bf_hi(ux[s + 2]) + k1b[3] * pg8::bf_hi(ux[s + 3]);
                c0 = a0 * c0 + pg8::bf_lo(ub[s]) * xc0; c1 = a1 * c1 + pg8::bf_hi(ub[s]) * xc1;
                po[(size_t)s * 32] = pg8::cvt_pk_bf16(c0 * pg8::bf_lo(uy[s]), c1 * pg8::bf_hi(uy[s])); }
            __syncthreads();
            if (seg == 31) { sC[2 * cp] = c0; sC[2 * cp + 1] = c1; }
            __syncthreads();
        }
    }
}

struct Args { const float* in[20]; float* out; unsigned char* ws; int n_sub; int pad; };
__global__ void __launch_bounds__(NWAVES * 64, 2) mega_fwd(Args args) {
    extern __shared__ __attribute__((aligned(16))) unsigned char lds[];
    Frame F;
    F.lds = (LAS unsigned char*)lds;
    F.MISC = (volatile LAS unsigned*)(F.lds + MISC_OFF);
    F.tid = threadIdx.x; F.lane = F.tid & 63; F.wave = __builtin_amdgcn_readfirstlane(F.tid >> 6);
    F.G = gridDim.x; { const int bx = blockIdx.x; F.vcu = (F.G % 8 == 0) ? (bx % 8) * (F.G / 8) + bx / 8 : bx; }
    F.out = args.out; F.ws = args.ws;
    unsigned char* ws = args.ws;
    for (int u = F.tid; u < (LDS_BYTES - LDSCTL_OFF) / 4; u += NWAVES * 64) ((LAS unsigned*)(F.lds + LDSCTL_OFF))[u] = 0u;
    __syncthreads();
    XcdBarrier bar = xcd_barrier_post((unsigned*)(ws + WS_CTL) + CW_BAR, F.MISC + 8);
#define GRID_BAR() xcd_barrier(bar, F.wave)
    group_barrier_post((unsigned*)(ws + WS_CTL), blockIdx.x & 7u);
    group_barrier_post((unsigned*)(ws + WS_CTL), 8u + (blockIdx.x & 7u) * 8u + ((blockIdx.x >> 3) & 7u));
#define GROUP_BAR() group_barrier((unsigned*)(ws_ + WS_CTL), (unsigned)opq_bx() & 7u, F.MISC + 10, F.wave)
#define QUAD_BAR() group_barrier((unsigned*)(ws_ + WS_CTL), 8u + ((unsigned)opq_bx() & 7u) * 8u + (((unsigned)opq_bx() >> 3) & 7u), F.MISC + 12, F.wave)


    p0_prologue(F);
    GRID_BAR();

    const int n_sub = args.n_sub;
    for (int sub = 0; sub < n_sub; ++sub) {
        const int L = sub >> 1, j = L >> 1;
        F.vcu = opq_i(F.vcu);
        unsigned char* ws_ = opq_p(args.ws);
        bf16* HB = (bf16*)(ws_ + WS_HB); float* SSQ = (float*)(ws_ + WS_SSQ); unsigned char* BIG = ws_ + WS_BIG;
        unsigned char* ar = arena_of(F, L);
        pg8::Gemm gr; const float* rbias = nullptr;
        if ((sub & 1) == 0) {
            if ((L & 1) == 0) {
                { pg8::Gemm g{(const char*)HB, (size_t)256 * DM * 2, (const bf16*)(ar + AR_MIX), DM, 64, 32768}; pg8::StaticOrder S; S.init(TOK, 3 * DM, F.G, opq_bx());
                  pg8::EpiQKV E{BIG, SSQ};
                  pg8::gemm_phase<pg8::EpiQKV, 0, true, true>(F.lds + RING_OFF, g, S, E, F.wave); }
                GROUP_BAR();
                { const int vc = opq_i(F.vcu); const int bh = vc >> 1, half = vc & 1; const float* tab = (const float*)(ws_ + WS_TEXT) + ((size_t)j * NH + (bh & 15)) * 320;
                  att::attn_table(tab, F.lds + RING_OFF, F.wave);
                  att::attn_stream(bh >> 4, bh & 15, half, BIG, tab, F.lds + RING_OFF, F.wave); }
                GROUP_BAR();
                gr = pg8::Gemm{(const char*)(BIG + pg8::PO_O), pg8::PANEL_BYTES, (const bf16*)(ar + AR_WO), DM, 64, 32768};
            } else {
                if (opq_bx() < BATCH) { const int tz = pg8::tid_of(F.wave); if (tz < 384) { const unsigned z = (unsigned)opq_v(0);
                    *(GAS v4u*)((bf16*)(BIG + (size_t)(opq_bx() * 8) * pg8::PANEL_BYTES + pg8::PO_X) + (size_t)(tz / 24) * pg8::KTX + (tz % 24) * 8) = (v4u){z, z, z, z}; } }
                { pg8::Gemm g{(const char*)HB, (size_t)256 * DM * 2, (const bf16*)(ar + AR_MIX), DM, 64, 32768}; pg8::StaticOrder S; S.init(TOK, 2 * DM, F.G, opq_bx());
                  pg8::EpiIn E{BIG, SSQ, inp(7) + (size_t)j * 2 * DM};
                  pg8::gemm_phase<pg8::EpiIn, 0, true, true>(F.lds + RING_OFF, g, S, E, F.wave); }
                GROUP_BAR();
                { pg8::Gemm g{(const char*)(BIG + pg8::PO_X), pg8::PANEL_BYTES, (const bf16*)(ar + AR_WG), 512, 64, 0}; pg8::StaticOrder S; S.init(TOK, 2 * DM, F.G, opq_bx());
                  pg8::EpiGate E{BIG, (const float*)(ws_ + WS_GC) + (size_t)j * DM * 8};
                  pg8::gemm_phase<pg8::EpiGate, 1, true, true>(F.lds + RING_OFF, g, S, E, F.wave); }
                GROUP_BAR();
                scan_phase(F, BIG, (const float*)(ws_ + WS_GC) + (size_t)j * DM * 8);
                GROUP_BAR();
                gr = pg8::Gemm{(const char*)(BIG + pg8::PO_G), pg8::PANEL_BYTES, (const bf16*)(ar + AR_WO), DM, 64, 32768}; rbias = inp(16) + (size_t)j * DM;
            }
        } else {
            { pg8::Gemm g{(const char*)HB, (size_t)256 * DM * 2, (const bf16*)(ar + AR_W1), DM, 64, 32768}; pg8::StaticOrder S; S.init(TOK, FF, F.G, opq_bx());
              pg8::EpiUp E{BIG, SSQ};
              pg8::gemm_phase<pg8::EpiUp, 0, true, true>(F.lds + RING_OFF, g, S, E, F.wave); }
            QUAD_BAR();
            gr = pg8::Gemm{(const char*)(BIG + pg8::PO_Z), pg8::PANEL_BYTES, (const bf16*)(ar + AR_W2), FF, 64, 32768};
        }
        { pg8::StaticOrder S; S.init(TOK, DM, F.G, opq_bx());
          pg8::EpiRes E{HB, SSQ, rbias};
          pg8::gemm_phase<pg8::EpiRes, 0, false, true>(F.lds + RING_OFF, gr, S, E, F.wave); }
        QUAD_BAR();
    }
    GRID_BAR();
    F.tid = pg8::tid_of(F.wave); F.lane = F.tid & 63;
    if (n_sub == 2 * DEPTH) { final_norm(F); }
}

#if FAST_SUBS < 8
namespace nv {
constexpr int D = 1024, B = 8, S = 2048, DEPTH = 4, H = 16, HD = 64, CH = 64, LEFT = 8, BAND = 9 * 64, MAXREL = 128, NREL = 257;
constexpr int DR = 1024, NB = 8, RB = 128, FF = 4096;

__global__ void rmsnorm_k(const float* x, const float* __restrict__ g, float* y) {
    const int row = blockIdx.x, tid = threadIdx.x;
    const float* xr = x + (size_t)row * D;
    float v[4], s = 0.f;
#pragma unroll
    for (int i = 0; i < 4; ++i) { v[i] = xr[tid + 256 * i]; s += v[i] * v[i]; }
    __shared__ float red[256];
    red[tid] = s; __syncthreads();
    for (int o = 128; o > 0; o >>= 1) { if (tid < o) red[tid] += red[tid + o]; __syncthreads(); }
    const float rstd = rsqrtf(red[0] / D + 1e-6f);
#pragma unroll
    for (int i = 0; i < 4; ++i) y[(size_t)row * D + tid + 256 * i] = v[i] * rstd * g[tid + 256 * i];
}

__global__ void gemm_k(const float* __restrict__ A, int lda, const float* __restrict__ Bm, int ldb, float* C, int ldc,
                       const float* __restrict__ bias, const float* res, int ldr, int K, int act) {
    __shared__ float As[16][64 + 1], Bs[16][64 + 1];
    const int tx = threadIdx.x & 15, ty = threadIdx.x >> 4, m0 = blockIdx.y * 64, n0 = blockIdx.x * 64;
    float acc[4][4] = {};
    for (int k0 = 0; k0 < K; k0 += 16) {
        for (int i = threadIdx.x; i < 64 * 16; i += 256) { const int r = i >> 4, c = i & 15; As[c][r] = A[(size_t)(m0 + r) * lda + k0 + c]; }
        for (int i = threadIdx.x; i < 16 * 64; i += 256) { const int r = i >> 6, c = i & 63; Bs[r][c] = Bm[(size_t)(k0 + r) * ldb + n0 + c]; }
        __syncthreads();
#pragma unroll
        for (int kk = 0; kk < 16; ++kk) {
            float a[4], b[4];
#pragma unroll
            for (int i = 0; i < 4; ++i) { a[i] = As[kk][ty * 4 + i]; b[i] = Bs[kk][tx * 4 + i]; }
#pragma unroll
            for (int i = 0; i < 4; ++i)
#pragma unroll
                for (int j = 0; j < 4; ++j) acc[i][j] += a[i] * b[j];
        }
        __syncthreads();
    }
#pragma unroll
    for (int i = 0; i < 4; ++i)
#pragma unroll
        for (int j = 0; j < 4; ++j) {
            const int r = m0 + ty * 4 + i, c = n0 + tx * 4 + j;
            float v = acc[i][j];
            if (bias) v += bias[c];
            if (act == 1) { v = fmaxf(v, 0.f); v = v * v; }
            if (res) v += res[(size_t)r * ldr + c];
            C[(size_t)r * ldc + c] = v;
        }
}

__global__ void __launch_bounds__(64) attn_k(const float* __restrict__ qkv, const float* __restrict__ table, float* __restrict__ o) {
    const int c = blockIdx.x, h = blockIdx.y, qi = threadIdx.x, t = c * CH + qi;
    float q[HD], acc[HD];
#pragma unroll
    for (int d = 0; d < HD; ++d) { q[d] = qkv[(size_t)t * 3 * D + h * HD + d]; acc[d] = 0.f; }
    const int k0 = c * CH - LEFT * CH;
    float m = -1e30f;
    for (int j = 0; j < BAND; ++j) {
        const int kp = k0 + j; if (kp < 0) continue;
        const float* kr = qkv + (size_t)kp * 3 * D + D + h * HD;
        float s = 0.f;
    #pragma unroll
    for (int d = 0; d < HD; ++d) s += q[d] * kr[d];
        int rel = t - kp; rel = rel < -MAXREL ? -MAXREL : (rel > MAXREL ? MAXREL : rel);
        s = s * 0.125f + table[h * NREL + rel + MAXREL];
        m = fmaxf(m, s);
    }
    float l = 0.f;
    for (int j = 0; j < BAND; ++j) {
        const int kp = k0 + j; if (kp < 0) continue;
        const float* kr = qkv + (size_t)kp * 3 * D + D + h * HD;
        const float* vr = qkv + (size_t)kp * 3 * D + 2 * D + h * HD;
        float s = 0.f;
    #pragma unroll
    for (int d = 0; d < HD; ++d) s += q[d] * kr[d];
        int rel = t - kp; rel = rel < -MAXREL ? -MAXREL : (rel > MAXREL ? MAXREL : rel);
        s = s * 0.125f + table[h * NREL + rel + MAXREL];
        const float p = expf(s - m);
        l += p;
    #pragma unroll
    for (int d = 0; d < HD; ++d) acc[d] += p * vr[d];
    }
    const float il = 1.f / l;
#pragma unroll
    for (int d = 0; d < HD; ++d) o[(size_t)t * D + h * HD + d] = acc[d] * il;
}

__global__ void conv_k(const float* __restrict__ u, const float* __restrict__ cw, const float* __restrict__ cb, float* __restrict__ xc) {
    const int t = blockIdx.x;
    for (int ch = threadIdx.x; ch < DR; ch += 256) {
        float v = cb[ch];
        for (int tap = 0; tap < 4; ++tap) { const int tt = t - 3 + tap; if (tt >= 0) v += u[(size_t)tt * 2 * DR + ch] * cw[tap * DR + ch]; }
        xc[(size_t)t * DR + ch] = v;
    }
}

__global__ void gates_k(const float* __restrict__ xc, const float* __restrict__ wga, const float* __restrict__ bga, const float* __restrict__ wgx,
                        const float* __restrict__ bgx, const float* __restrict__ ap, float* __restrict__ a, float* __restrict__ bq) {
    const int t = blockIdx.x;
    __shared__ float xr[DR];
    for (int i = threadIdx.x; i < DR; i += 256) xr[i] = xc[(size_t)t * DR + i];
    __syncthreads();
    for (int e = threadIdx.x; e < DR; e += 256) {
        const int n = e / RB, ee = e % RB;
        float sa = bga[e], sx = bgx[e];
        for (int c2 = 0; c2 < RB; ++c2) { const float xv = xr[n * RB + c2]; sa += xv * wga[((size_t)n * RB + c2) * RB + ee]; sx += xv * wgx[((size_t)n * RB + c2) * RB + ee]; }
        const float r = 1.f / (1.f + expf(-sa)), ig = 1.f / (1.f + expf(-sx));
        const float L = ap[e];
        const float sp = log1pf(expf(-L));
        const float log_a = -8.f * r * sp;
        const float av = expf(log_a);
        const float mult = sqrtf(-expm1f(2.f * log_a));
        a[(size_t)t * DR + e] = av;
        bq[(size_t)t * DR + e] = mult * (ig * xr[e]);
    }
}

__global__ void scan_k(const float* __restrict__ a, const float* __restrict__ bq, const float* __restrict__ u, float* __restrict__ out) {
    const int ch = blockIdx.x * blockDim.x + threadIdx.x;
    float hs = 0.f;
    for (int t = 0; t < S; ++t) {
        hs = a[(size_t)t * DR + ch] * hs + bq[(size_t)t * DR + ch];
        const float y = u[(size_t)t * 2 * DR + DR + ch];
        const float gy = 0.5f * y * (1.f + tanhf(0.7978845608028654f * (y + 0.044715f * y * y * y)));
        out[(size_t)t * DR + ch] = hs * gy;
    }
}
}
#endif
#if FAST_SUBS < 8
__global__ void dbg_bf2f(const unsigned short* in, float* out, size_t n) { for (size_t i = (size_t)blockIdx.x * blockDim.x + threadIdx.x; i < n; i += (size_t)gridDim.x * blockDim.x) { const size_t m = i >> 10, c = i & 1023; out[i] = __uint_as_float((unsigned)in[(m >> 8) * (256 * 1024) + (c >> 6) * (256 * 64) + (m & 255) * 64 + (c & 63)] << 16); } }
#endif
extern "C" void kernel_launch(void* const* d_in, const int* in_sizes, int n_in, void* d_out, int out_size, void* d_ws, size_t ws_size, hipStream_t stream) {
    static int grid = 0;
    if (grid == 0) {
        int dev = 0, cus = 0;
        if (n_in != 20 || out_size != TOK * DM || ws_size < WS_END) { fprintf(stderr, "kernel_launch: unexpected shapes (n_in %d out %d ws %zu)\n", n_in, out_size, ws_size); grid = -1; return; }
        if (hipGetDevice(&dev) != hipSuccess || hipDeviceGetAttribute(&cus, hipDeviceAttributeMultiprocessorCount, dev) != hipSuccess) { grid = -1; return; }
        if (hipFuncSetAttribute((const void*)mega_fwd, hipFuncAttributeMaxDynamicSharedMemorySize, LDS_BYTES) != hipSuccess) { fprintf(stderr, "kernel_launch: hipFuncSetAttribute failed\n"); grid = -1; return; }
        (void)hipGetLastError();
        grid = cus;
        if (grid != 256) fprintf(stderr, "kernel_launch: %d CUs; this kernel is built for 256\n", grid);
    }
    if (grid < 0) return;
    (void)hipMemsetAsync((char*)d_ws + WS_CTL, 0, CTL_ZERO_BYTES, stream);
    Args a{};
    for (int i = 0; i < 20; ++i) a.in[i] = (const float*)d_in[i];
    a.out = (float*)d_out; a.ws = (unsigned char*)d_ws; a.n_sub = FAST_SUBS; a.pad = 0;
    hipLaunchKernelGGL(mega_fwd, dim3(grid), dim3(NWAVES * 64), LDS_BYTES, stream, a);
#if FAST_SUBS < 8
    {
        using namespace nv;
        const float* norm_mix = (const float*)d_in[1]; const float* norm_mlp = (const float*)d_in[2];
        const float* w_qkv = (const float*)d_in[3]; const float* w_o = (const float*)d_in[4]; const float* rel = (const float*)d_in[5];
        const float* r_win = (const float*)d_in[6]; const float* r_bin = (const float*)d_in[7]; const float* r_cw = (const float*)d_in[8]; const float* r_cb = (const float*)d_in[9];
        const float* r_wga = (const float*)d_in[10]; const float* r_bga = (const float*)d_in[11]; const float* r_wgx = (const float*)d_in[12]; const float* r_bgx = (const float*)d_in[13];
        const float* r_ap = (const float*)d_in[14]; const float* r_wo = (const float*)d_in[15]; const float* r_bo = (const float*)d_in[16];
        const float* w1 = (const float*)d_in[17]; const float* w2 = (const float*)d_in[18]; const float* norm_final = (const float*)d_in[19];
        float* h = (float*)d_out; float* wsf = (float*)((char*)d_ws + 64 * MiB);
        float* hn = wsf; float* big = hn + (size_t)S * D; float* t1 = big + (size_t)S * FF; float* t2 = t1 + (size_t)S * D; float* t3 = t2 + (size_t)S * D;
        if (FAST_SUBS == 0) (void)hipMemcpyAsync(h, d_in[0], (size_t)B * S * D * 4, hipMemcpyDeviceToDevice, stream);
        else dbg_bf2f<<<4096, 256, 0, stream>>>((const unsigned short*)((char*)d_ws + WS_HB), h, (size_t)B * S * D);
        for (int sub = FAST_SUBS; sub < 8; ++sub) {
            const int layer = sub >> 1, j = layer / 2;
            for (int b = 0; b < B; ++b) {
                float* hb = h + (size_t)b * S * D;
                if ((sub & 1) == 0) {
                    rmsnorm_k<<<S, 256, 0, stream>>>(hb, norm_mix + layer * D, hn);
                    if (layer % 2 == 0) {
                        gemm_k<<<dim3(3 * D / 64, S / 64), 256, 0, stream>>>(hn, D, w_qkv + (size_t)j * D * 3 * D, 3 * D, big, 3 * D, nullptr, nullptr, 0, D, 0);
                        attn_k<<<dim3(S / CH, H), 64, 0, stream>>>(big, rel + (size_t)j * H * NREL, t1);
                        gemm_k<<<dim3(D / 64, S / 64), 256, 0, stream>>>(t1, D, w_o + (size_t)j * D * D, D, hb, D, nullptr, hb, D, D, 0);
                    } else {
                        gemm_k<<<dim3(2 * DR / 64, S / 64), 256, 0, stream>>>(hn, D, r_win + (size_t)j * D * 2 * DR, 2 * DR, big, 2 * DR, r_bin + (size_t)j * 2 * DR, nullptr, 0, D, 0);
                        conv_k<<<S, 256, 0, stream>>>(big, r_cw + (size_t)j * 4 * DR, r_cb + (size_t)j * DR, t1);
                        gates_k<<<S, 256, 0, stream>>>(t1, r_wga + (size_t)j * NB * RB * RB, r_bga + (size_t)j * DR, r_wgx + (size_t)j * NB * RB * RB, r_bgx + (size_t)j * DR, r_ap + (size_t)j * DR, t2, t3);
                        scan_k<<<DR / 64, 64, 0, stream>>>(t2, t3, big, t1);
                        gemm_k<<<dim3(D / 64, S / 64), 256, 0, stream>>>(t1, DR, r_wo + (size_t)j * DR * D, D, hb, D, r_bo + (size_t)j * D, hb, D, DR, 0);
                    }
                } else {
                    rmsnorm_k<<<S, 256, 0, stream>>>(hb, norm_mlp + layer * D, hn);
                    gemm_k<<<dim3(FF / 64, S / 64), 256, 0, stream>>>(hn, D, w1 + (size_t)layer * D * FF, FF, big, FF, nullptr, nullptr, 0, D, 1);
                    gemm_k<<<dim3(D / 64, S / 64), 256, 0, stream>>>(big, FF, w2 + (size_t)layer * FF * D, D, hb, D, nullptr, hb, D, FF, 0);
                }
            }
        }
        for (int b = 0; b < B; ++b) { float* hb = h + (size_t)b * S * D; rmsnorm_k<<<S, 256, 0, stream>>>(hb, norm_final, hb); }
    }
#endif
}
```

```cpp
#include <hip/hip_runtime.h>
#include <hip/hip_bf16.h>
#include <cstdio>
#include <cstdint>
#include <math.h>
#ifndef FAST_SUBS
#define FAST_SUBS 8
#endif
namespace pg8 {
#define PG8_LAS __attribute__((address_space(3)))
typedef unsigned short bf16_t;
typedef short bf16x8 __attribute__((ext_vector_type(8)));
typedef float f32x4 __attribute__((ext_vector_type(4)));
typedef float f32x2 __attribute__((ext_vector_type(2)));
typedef unsigned u32x4 __attribute__((ext_vector_type(4)));
typedef unsigned u32x2 __attribute__((ext_vector_type(2)));
constexpr int BM = 256, BK = 64, HALF = 128, HTB = HALF * BK * 2  , STAGE_BYTES = 8 * HTB, NXCD = 8, WGM = 8;
constexpr int TOK = 16384, DMODEL = 1024, SEQL = 2048;
constexpr size_t PANEL_BYTES = 2752512;
constexpr int PO_Z = 0, PO_Q = 0, PO_K = 512 * 1024, PO_V = 1024 * 1024, PO_O = 1536 * 1024, PO_Y = 0, PO_AL = 512 * 1024, PO_BQ = 1024 * 1024, PO_G = 1536 * 1024, PO_X = 2048 * 1024;
static_assert((size_t)PO_X + 259 * 2048 <= PANEL_BYTES, "panel map");
constexpr int KT = 256 * 64, KTX = 259 * 64;

constexpr float RMS_EPS = 1e-6f;
constexpr float C2 = 0.125f * 1.4426950408889634f;

__host__ __device__ __forceinline__ int lds_byte(int r, int c) { const int st = (r >> 4) * 2 + (c >> 5), rr = r & 15, cc = c & 31, ob = rr * 64 + cc * 2; return st * 1024 + (ob ^ (((ob >> 9) & 1) << 5)); }
__host__ __device__ __forceinline__ void stage_rc(int b, int& R, int& C) { const int st = b / 1024, sb = b % 1024, swz = sb ^ (((sb >> 9) & 1) << 5); R = (st >> 1) * 16 + swz / 64; C = (st & 1) * 32 + (swz % 64) / 2; }
__host__ __device__ __forceinline__ int perm32(int rho) { const int n = rho >> 4, i = rho & 15; return 8 * (i >> 2) + 4 * n + (i & 3); }

struct Unit { int pm, pn; };
struct Gemm { const char* A; size_t apstride; const bf16_t* Bt; int K; int lda; int kts; };
template <int MODE> __device__ __forceinline__ const char* a_base(const Gemm& g, const Unit& u) {
    if (MODE == 0) return g.A + (size_t)u.pm * g.apstride;
    return g.A + (size_t)u.pm * g.apstride + (size_t)(2 * u.pn) * (KTX * 2);
}
template <int MODE> __device__ __forceinline__ size_t koff(const Gemm& g, int t) {
    if (MODE == 0) return (size_t)t * (size_t)g.kts;
    return (size_t)(t & 1) * (KTX * 2) + (size_t)(t >> 1) * 128;
}

struct StaticOrder {
    int nM, nN, nwg, G, c;
    __host__ __device__ void init(int M, int N, int G_, int c_) { nM = M / BM; nN = N / BM; nwg = nM * nN; G = G_; c = c_; }
    __host__ __device__ bool next(int i, Unit& u) const {
        const long L = (long)i * G + c; if (L >= nwg) return false;
        int wgid = (int)L; { const int q = nwg / NXCD, r = nwg % NXCD, xcd = wgid % NXCD, off = wgid / NXCD; wgid = (xcd < r ? xcd * (q + 1) : r * (q + 1) + (xcd - r) * q) + off; }
        const int nig = WGM * nN, gid = wgid / nig, fm = gid * WGM, gsz = (nM - fm) < WGM ? (nM - fm) : WGM;
        u.pm = fm + ((wgid % nig) % gsz); u.pn = (wgid % nig) / gsz; return true;
    }
};

__device__ __forceinline__ unsigned cvt_pk_bf16(float lo, float hi) { unsigned r; asm volatile("v_cvt_pk_bf16_f32 %0, %1, %2" : "=v"(r) : "v"(lo), "v"(hi)); return r; }
__device__ __forceinline__ void st16(bf16_t* p, u32x4 v) { *(u32x4*)p = v; }
__device__ __forceinline__ float quarter_sum(float s) {
    s += __int_as_float(__builtin_amdgcn_ds_swizzle(__float_as_int(s), 0x401F));
    const auto rr = __builtin_amdgcn_permlane32_swap(__float_as_uint(s), __float_as_uint(s), false, false);
    return __uint_as_float(rr[0]) + __uint_as_float(rr[1]);
}
__device__ __forceinline__ int tid_of(int wave) { unsigned m = ~0u; asm volatile("" : "+s"(m));
    return wave * 64 + (int)__builtin_amdgcn_mbcnt_hi(m, __builtin_amdgcn_mbcnt_lo(m, 0u)); }
__device__ __forceinline__ float bf_lo(unsigned u) { return __uint_as_float(u << 16); }
__device__ __forceinline__ float bf_hi(unsigned u) { return __uint_as_float(u & 0xffff0000u); }
constexpr int RSTD_LDS_OFF = 131072 + 2048;
__device__ __forceinline__ float rstd_of(const float* ssq, int row) {
    const float s = (ssq[row] + ssq[TOK + row]) + (ssq[2 * TOK + row] + ssq[3 * TOK + row]);
    return __builtin_amdgcn_rsqf(s * (1.0f / DMODEL) + RMS_EPS);
}


struct EpiQKV {
    static constexpr bool PERM = true, AFTER_DRAIN = false, NEED_RSTD = true;
    unsigned char* big; const float* ssq;
    __device__ __forceinline__ void operator()(const f32x4 (&acc)[2][2][4][2], const Unit& u, int wr, int wc, int fr, int fq, const PG8_LAS float* rstdL) const {
        const int t = u.pn >> 2; bf16_t* base = (bf16_t*)(big + (size_t)u.pm * PANEL_BYTES + PO_Q + (size_t)t * (PO_K - PO_Q)); const float sc0 = t == 0 ? C2 : 1.f;
        const int rl0 = wr * 64 + fr; const size_t co = (size_t)(4 * (u.pn & 3) + (wc >> 1)) * KT + 32 * (wc & 1) + 8 * fq;
#pragma unroll
        for (int ai = 0; ai < 2; ++ai)
#pragma unroll
            for (int m = 0; m < 4; ++m) { const int rl = rl0 + ai * HALF + m * 16; const float sc = rstdL[rl] * sc0; bf16_t* rowp = base + co + (size_t)rl * 64;
#pragma unroll
                for (int bj = 0; bj < 2; ++bj) { const f32x4 v0 = acc[ai][bj][m][0] * sc, v1 = acc[ai][bj][m][1] * sc;
                    u32x4 w; w.x = cvt_pk_bf16(v0[0], v0[1]); w.y = cvt_pk_bf16(v0[2], v0[3]); w.z = cvt_pk_bf16(v1[0], v1[1]); w.w = cvt_pk_bf16(v1[2], v1[3]);
                    *(u32x4*)(rowp + (size_t)bj * (2 * KT)) = w; } }
    }
};
struct EpiUp {
    static constexpr bool PERM = true, AFTER_DRAIN = false, NEED_RSTD = true;
    unsigned char* big; const float* ssq;
    __device__ __forceinline__ void operator()(const f32x4 (&acc)[2][2][4][2], const Unit& u, int wr, int wc, int fr, int fq, const PG8_LAS float* rstdL) const {
        bf16_t* base = (bf16_t*)(big + (size_t)u.pm * PANEL_BYTES + PO_Z);
        const int rl0 = wr * 64 + fr; const size_t co = (size_t)(4 * u.pn + (wc >> 1)) * 16384 + 32 * (wc & 1) + 8 * fq;
#pragma unroll
        for (int ai = 0; ai < 2; ++ai)
#pragma unroll
            for (int m = 0; m < 4; ++m) { const int rl = rl0 + ai * HALF + m * 16; const float sc = rstdL[rl]; bf16_t* rowp = base + co + (size_t)rl * 64;
#pragma unroll
                for (int bj = 0; bj < 2; ++bj) { f32x4 v0 = acc[ai][bj][m][0] * sc, v1 = acc[ai][bj][m][1] * sc;
#pragma unroll
                    for (int i = 0; i < 4; ++i) { v0[i] = fmaxf(v0[i], 0.f); v1[i] = fmaxf(v1[i], 0.f); }
                    v0 = v0 * v0; v1 = v1 * v1;
                    u32x4 w; w.x = cvt_pk_bf16(v0[0], v0[1]); w.y = cvt_pk_bf16(v0[2], v0[3]); w.z = cvt_pk_bf16(v1[0], v1[1]); w.w = cvt_pk_bf16(v1[2], v1[3]);
                    st16(rowp + (size_t)bj * 32768, w); } }
    }
};
__device__ __forceinline__ float gelu_tanh(float v) {
    const float z = v * (1.0f + 0.044715f * v * v) * (-2.0f * 0.7978845608028654f * 1.4426950408889634f);
    return v * __builtin_amdgcn_rcpf(1.0f + __builtin_amdgcn_exp2f(z));
}
struct EpiIn {
    static constexpr bool PERM = true, AFTER_DRAIN = false, NEED_RSTD = true;
    unsigned char* big; const float* ssq; const float* bias;
    __device__ __forceinline__ void operator()(const f32x4 (&acc)[2][2][4][2], const Unit& u, int wr, int wc, int fr, int fq, const PG8_LAS float* rstdL) const {
        const bool isy = u.pn >= 4, has_nxt = (u.pm & 7) != 7;
        unsigned char* pan = big + (size_t)u.pm * PANEL_BYTES;
        asm volatile("" : "+v"(fr));
        const int rl0 = wr * 64 + fr, ktl = 4 * (u.pn & 3) + (wc >> 1), cl = 32 * (wc & 1) + 8 * fq, bcol0 = u.pn * BM + wc * 32 + 8 * fq;
        f32x4 bv[2][2];
#pragma unroll
        for (int bj = 0; bj < 2; ++bj)
#pragma unroll
            for (int n = 0; n < 2; ++n) bv[bj][n] = *(const f32x4*)(bias + bcol0 + bj * HALF + 4 * n);
#pragma unroll
        for (int ai = 0; ai < 2; ++ai)
#pragma unroll
            for (int m = 0; m < 4; ++m) { const int rl = rl0 + ai * HALF + m * 16; const float sc = rstdL[rl];
                const size_t kst = isy ? (size_t)KT : (size_t)KTX;
                bf16_t* rowp = isy ? ((bf16_t*)(pan + PO_Y) + (size_t)ktl * KT + (size_t)rl * 64 + cl) : ((bf16_t*)(pan + PO_X) + (size_t)ktl * KTX + (size_t)(rl + 3) * 64 + cl);
                const bool halo = !isy && has_nxt && rl >= BM - 3;
                bf16_t* hrow = (bf16_t*)(pan + PANEL_BYTES + PO_X) + (size_t)ktl * KTX + (size_t)(rl - (BM - 3)) * 64 + cl;
#pragma unroll
                for (int bj = 0; bj < 2; ++bj) { f32x4 v0 = acc[ai][bj][m][0] * sc + bv[bj][0], v1 = acc[ai][bj][m][1] * sc + bv[bj][1];
                    if (isy) {
#pragma unroll
                        for (int i = 0; i < 4; ++i) { v0[i] = gelu_tanh(v0[i]); v1[i] = gelu_tanh(v1[i]); } }
                    u32x4 w; w.x = cvt_pk_bf16(v0[0], v0[1]); w.y = cvt_pk_bf16(v0[2], v0[3]); w.z = cvt_pk_bf16(v1[0], v1[1]); w.w = cvt_pk_bf16(v1[2], v1[3]);
                    *(u32x4*)(rowp + (size_t)bj * 2 * kst) = w;
                    if (halo) *(u32x4*)(hrow + (size_t)bj * 2 * KTX) = w; } }
    }
};
struct EpiGate {
    static constexpr bool PERM = true, AFTER_DRAIN = false, NEED_RSTD = false;
    unsigned char* big; const float* gc;
    __device__ __forceinline__ void operator()(const f32x4 (&acc)[2][2][4][2], const Unit& u, int wr, int wc, int fr, int fq, const PG8_LAS float*) const {
        const int rl0 = wr * 64 + fr, ch0 = u.pn * 128 + wc * 32 + 8 * fq;
        bf16_t* AL = (bf16_t*)(big + (size_t)u.pm * PANEL_BYTES + PO_AL); bf16_t* BQ = (bf16_t*)(big + (size_t)u.pm * PANEL_BYTES + PO_BQ);
        float ba[8], bx[8], c8[8];
#pragma unroll
        for (int i = 0; i < 8; ++i) { const f32x4 c = *(const f32x4*)(gc + (size_t)(ch0 + i) * 8); ba[i] = c[0]; bx[i] = c[1]; c8[i] = c[3]; }
#pragma unroll
        for (int ai = 0; ai < 2; ++ai)
#pragma unroll
            for (int m = 0; m < 4; ++m) { const int row = rl0 + ai * HALF + m * 16;
                float la2[8], bq[8];
#pragma unroll
                for (int i = 0; i < 8; ++i) { const float ga = acc[ai][0][m][i >> 2][i & 3], gx = acc[ai][1][m][i >> 2][i & 3];
                    const float r = __builtin_amdgcn_rcpf(1.0f + __builtin_amdgcn_exp2f(-(ga + ba[i]) * 1.4426950408889634f));
                    const float ig = __builtin_amdgcn_rcpf(1.0f + __builtin_amdgcn_exp2f(-(gx + bx[i]) * 1.4426950408889634f));
                    la2[i] = c8[i] * r;
                    const float om = 1.0f - __builtin_amdgcn_exp2f(2.0f * la2[i]);
                    bq[i] = __builtin_amdgcn_sqrtf(om) * ig; }
                u32x4 wa, wb;
                wa.x = cvt_pk_bf16(la2[0], la2[1]); wa.y = cvt_pk_bf16(la2[2], la2[3]); wa.z = cvt_pk_bf16(la2[4], la2[5]); wa.w = cvt_pk_bf16(la2[6], la2[7]);
                wb.x = cvt_pk_bf16(bq[0], bq[1]); wb.y = cvt_pk_bf16(bq[2], bq[3]); wb.z = cvt_pk_bf16(bq[4], bq[5]); wb.w = cvt_pk_bf16(bq[6], bq[7]);
                const size_t eo = (size_t)(2 * u.pn + (wc >> 1)) * KT + (size_t)row * 64 + 32 * (wc & 1) + 8 * fq;
                *(u32x4*)(AL + eo) = wa; *(u32x4*)(BQ + eo) = wb;
            }
    }
};
struct EpiRes {
    static constexpr bool PERM = true, AFTER_DRAIN = true, NEED_RSTD = false;
    bf16_t* hb; float* ssq; const float* bias;
    __device__ __forceinline__ void prefetch(u32x4 (&pre)[4][2], const Unit& u, int wr, int wc, int fr, int fq) const {
        const bf16_t* hbp = hb + (size_t)u.pm * (BM * DMODEL) + (size_t)(4 * u.pn + (wc >> 1)) * KT + 32 * (wc & 1) + 8 * fq;
#pragma unroll
        for (int m = 0; m < 4; ++m)
#pragma unroll
            for (int bj = 0; bj < 2; ++bj) pre[m][bj] = *(const u32x4*)(hbp + (size_t)(wr * 64 + m * 16 + fr) * 64 + (size_t)bj * (2 * KT));
    }
    __device__ __forceinline__ void fused(f32x4 (&acc)[2][2][4][2], const u32x4 (&pre)[4][2], const Unit& u, int wr, int wc, int fr, int fq, PG8_LAS unsigned char* lds, int wid, int lane) const {
        PG8_LAS float* P = (PG8_LAS float*)lds;
        const int col0 = u.pn * BM + wc * 32 + 8 * fq;
        bf16_t* hbp = hb + (size_t)u.pm * (BM * DMODEL) + (size_t)(4 * u.pn + (wc >> 1)) * KT + 32 * (wc & 1) + 8 * fq;
        f32x4 bv[2][2];
#pragma unroll
        for (int bj = 0; bj < 2; ++bj)
#pragma unroll
            for (int n = 0; n < 2; ++n) bv[bj][n] = bias ? *(const f32x4*)(bias + col0 + bj * HALF + 4 * n) : (f32x4){0.f, 0.f, 0.f, 0.f};
#pragma unroll
        for (int ai = 0; ai < 2; ++ai) {
            u32x4 rr[4][2];
#pragma unroll
            for (int m = 0; m < 4; ++m)
#pragma unroll
                for (int bj = 0; bj < 2; ++bj) rr[m][bj] = (ai == 0) ? pre[m][bj] : *(const u32x4*)(hbp + (size_t)(ai * HALF + wr * 64 + m * 16 + fr) * 64 + (size_t)bj * (2 * KT));
#pragma unroll
            for (int m = 0; m < 4; ++m) { const int rl = ai * HALF + wr * 64 + m * 16 + fr;
                float s = 0.f;
#pragma unroll
                for (int bj = 0; bj < 2; ++bj) { const u32x4 r = rr[m][bj];
                    const f32x4 r0 = (f32x4){bf_lo(r.x), bf_hi(r.x), bf_lo(r.y), bf_hi(r.y)}, r1 = (f32x4){bf_lo(r.z), bf_hi(r.z), bf_lo(r.w), bf_hi(r.w)};
                    const f32x4 v0 = acc[ai][bj][m][0] + bv[bj][0] + r0, v1 = acc[ai][bj][m][1] + bv[bj][1] + r1;
                    s += (v0[0] * v0[0] + v0[1] * v0[1]) + (v0[2] * v0[2] + v0[3] * v0[3]) + (v1[0] * v1[0] + v1[1] * v1[1]) + (v1[2] * v1[2] + v1[3] * v1[3]);
                    u32x4 w; w.x = cvt_pk_bf16(v0[0], v0[1]); w.y = cvt_pk_bf16(v0[2], v0[3]); w.z = cvt_pk_bf16(v1[0], v1[1]); w.w = cvt_pk_bf16(v1[2], v1[3]);
                    *(u32x4*)(hbp + (size_t)rl * 64 + (size_t)bj * (2 * KT)) = w;
                }
                s = quarter_sum(s);
                if (fq == 0) P[wc * 256 + rl] = s;
            }
            asm volatile("" ::: "memory");
        }
        asm volatile("s_waitcnt lgkmcnt(0)" ::: "memory"); __builtin_amdgcn_s_barrier(); asm volatile("" ::: "memory");
        const int tid = wid * 64 + lane;
        if (tid < 256) { const float s = (P[tid] + P[256 + tid]) + (P[512 + tid] + P[768 + tid]); ssq[(size_t)u.pn * TOK + u.pm * BM + tid] = s; }
    }
};

template <class Epi, int MODE, bool ALIGN_EPI = false, bool SP2 = false>
__device__ __forceinline__ void gemm_phase(PG8_LAS unsigned char* lds, const Gemm g, const StaticOrder& S, const Epi& E, int wave) {
    int tid_ = tid_of(wave); asm volatile("" : "+v"(tid_));
    const int tid = tid_, wid = __builtin_amdgcn_readfirstlane(tid >> 6), lane = tid & 63, wr = wid >> 2, wc = wid & 3, fr = lane & 15, fq = lane >> 4;
    const int K = g.K, nt = K / BK, lda = g.lda;
    unsigned voffA[2], voffB[2];
#pragma unroll
    for (int i = 0; i < 2; ++i) { int R, C; stage_rc(tid * 16 + i * 8192, R, C); const int Rb = Epi::PERM ? ((R & ~31) + perm32(R & 31)) : R;
        voffA[i] = (unsigned)(R * lda + C) * 2u; voffB[i] = (unsigned)(Rb * K + C) * 2u; }
    const size_t kstep = (size_t)(BK * 2);
    const size_t hstepA = (size_t)HALF * lda * 2, hstepB = (size_t)HALF * K * 2;
    const unsigned ldsw = (unsigned)wid * 1024u;
    const int aoff = lds_byte(wr * 64 + fr, fq * 8), boff = lds_byte(wc * 32 + fr, fq * 8);
#define PG8_SA(b, h) (((b) * 2 + (h)) * HTB)
#define PG8_SB(b, h) ((4 + (b) * 2 + (h)) * HTB)
#define PG8_STAGE(bufoff, gbase, voff) do { _Pragma("unroll") for (int _i = 0; _i < 2; ++_i) \
        __builtin_amdgcn_global_load_lds((const unsigned*)((const char*)(gbase) + (voff)[_i]), (PG8_LAS unsigned*)(lds + (bufoff) + ldsw + _i * 8192), 16, 0, 0); } while (0)
#define PG8_LDA(dst, b, h) do { _Pragma("unroll") for (int m = 0; m < 4; ++m) _Pragma("unroll") for (int k = 0; k < 2; ++k) dst[m][k] = *(const PG8_LAS bf16x8*)(lds + PG8_SA(b, h) + aoff + m * 2048 + k * 1024); } while (0)
#define PG8_LDB(dst, b, h) do { _Pragma("unroll") for (int n = 0; n < 2; ++n) _Pragma("unroll") for (int k = 0; k < 2; ++k) dst[n][k] = *(const PG8_LAS bf16x8*)(lds + PG8_SB(b, h) + boff + n * 2048 + k * 1024); } while (0)
#define PG8_MMA(ai, bj, At, Bt) do { __builtin_amdgcn_s_setprio(1); _Pragma("unroll") for (int m = 0; m < 4; ++m) _Pragma("unroll") for (int n = 0; n < 2; ++n) _Pragma("unroll") for (int k = 0; k < 2; ++k) \
        acc[ai][bj][m][n] = __builtin_amdgcn_mfma_f32_16x16x32_bf16(Bt[n][k], At[m][k], acc[ai][bj][m][n], 0, 0, 0); __builtin_amdgcn_s_setprio(0); } while (0)
#define PG8_WAIT_V(n) asm volatile("s_waitcnt vmcnt(" #n ")" ::: "memory")
#define PG8_WAIT_L(n) asm volatile("s_waitcnt lgkmcnt(" #n ")" ::: "memory")
#define PG8_BAR __builtin_amdgcn_s_barrier()
#define PG8_SCHED __builtin_amdgcn_sched_barrier(0)
    Unit cur, nxt; int ui = 0;
    if (!S.next(0, cur)) return;
    f32x4 acc[2][2][4][2];
#pragma unroll
    for (int a = 0; a < 2; ++a)
#pragma unroll
        for (int b = 0; b < 2; ++b)
#pragma unroll
            for (int m = 0; m < 4; ++m)
#pragma unroll
                for (int n = 0; n < 2; ++n) acc[a][b][m][n] = (f32x4){0.f, 0.f, 0.f, 0.f};
    bf16x8 At[4][2], B0[2][2], B1[2][2];
    const char* cA = a_base<MODE>(g, cur); const char* cB = (const char*)g.Bt + (size_t)cur.pn * 2 * hstepB;
    const size_t ko1 = koff<MODE>(g, 1);
    const PG8_LAS float* rstdL = (const PG8_LAS float*)(lds + RSTD_LDS_OFF);
    float my_rstd = 0.f;
    if constexpr (Epi::NEED_RSTD) { if (tid < BM) my_rstd = rstd_of(E.ssq, cur.pm * BM + tid); }
    if constexpr (SP2) {
        PG8_STAGE(PG8_SB(0, 0), cB, voffB); PG8_STAGE(PG8_SB(0, 1), cB + hstepB, voffB); PG8_STAGE(PG8_SA(0, 0), cA, voffA); PG8_STAGE(PG8_SA(0, 1), cA + hstepA, voffA);
        if (wr == 1) PG8_BAR;
        PG8_WAIT_V(2); PG8_BAR;
        PG8_STAGE(PG8_SB(1, 0), cB + kstep, voffB); PG8_STAGE(PG8_SA(1, 0), cA + ko1, voffA); PG8_STAGE(PG8_SB(1, 1), cB + hstepB + kstep, voffB);
        PG8_WAIT_V(6); PG8_BAR;
    } else {
        PG8_STAGE(PG8_SB(0, 0), cB, voffB); PG8_STAGE(PG8_SA(0, 0), cA, voffA); PG8_STAGE(PG8_SB(0, 1), cB + hstepB, voffB); PG8_STAGE(PG8_SA(0, 1), cA + hstepA, voffA);
        if (wr == 1) PG8_BAR;
        PG8_WAIT_V(4); PG8_BAR;
        PG8_STAGE(PG8_SB(1, 0), cB + kstep, voffB); PG8_STAGE(PG8_SA(1, 0), cA + ko1, voffA); PG8_STAGE(PG8_SB(1, 1), cB + hstepB + kstep, voffB);
        PG8_WAIT_V(6); PG8_BAR;
    }
    if constexpr (Epi::NEED_RSTD) { if (tid < BM) ((PG8_LAS float*)(lds + RSTD_LDS_OFF))[tid] = my_rstd; }
    for (;;) {
        const bool has_next = S.next(ui + 1, nxt);
        const char* nA = has_next ? a_base<MODE>(g, nxt) : cA; const char* nB = has_next ? (const char*)g.Bt + (size_t)nxt.pn * 2 * hstepB : cB;
        for (int t = 0; t < nt; t += 2) {
            const bool last = (t == nt - 2);
            const char* a1 = cA + koff<MODE>(g, t + 1);
            const char* a2 = last ? nA : cA + koff<MODE>(g, t + 2); const char* b2 = last ? nB : cB + (size_t)(t + 2) * kstep;
            const char* a3 = last ? nA + ko1 : cA + koff<MODE>(g, t + 3); const char* b3 = b2 + kstep;
            if constexpr (SP2) {
            PG8_LDB(B0, 0, 0); PG8_LDB(B1, 0, 1); PG8_SCHED; PG8_LDA(At, 0, 0); PG8_STAGE(PG8_SA(1, 1), a1 + hstepA, voffA);
            PG8_WAIT_V(8); PG8_WAIT_L(0); PG8_BAR; PG8_MMA(0, 0, At, B0); PG8_MMA(0, 1, At, B1); PG8_BAR; PG8_SCHED;
            PG8_LDA(At, 0, 1); PG8_STAGE(PG8_SB(0, 0), b2, voffB); PG8_STAGE(PG8_SB(0, 1), b2 + hstepB, voffB); PG8_STAGE(PG8_SA(0, 0), a2, voffA);
            PG8_WAIT_V(8); PG8_WAIT_L(0); PG8_BAR; PG8_MMA(1, 0, At, B0); PG8_MMA(1, 1, At, B1); PG8_BAR; PG8_SCHED;
            PG8_LDB(B0, 1, 0); PG8_LDB(B1, 1, 1); PG8_SCHED; PG8_LDA(At, 1, 0); PG8_STAGE(PG8_SA(0, 1), a2 + hstepA, voffA);
            PG8_WAIT_V(8); PG8_WAIT_L(0); PG8_BAR; PG8_MMA(0, 0, At, B0); PG8_MMA(0, 1, At, B1); PG8_BAR; PG8_SCHED;
            PG8_LDA(At, 1, 1); PG8_STAGE(PG8_SB(1, 0), b3, voffB); PG8_STAGE(PG8_SB(1, 1), b3 + hstepB, voffB); PG8_STAGE(PG8_SA(1, 0), a3, voffA);
            PG8_WAIT_V(8); PG8_WAIT_L(0); PG8_BAR; PG8_MMA(1, 0, At, B0); PG8_MMA(1, 1, At, B1); PG8_BAR; PG8_SCHED;
            } else {
            PG8_LDB(B0, 0, 0); PG8_SCHED; PG8_LDA(At, 0, 0); PG8_STAGE(PG8_SA(1, 1), a1 + hstepA, voffA);
            PG8_WAIT_L(8); PG8_BAR; PG8_WAIT_L(0); PG8_MMA(0, 0, At, B0); PG8_BAR; PG8_SCHED;
            PG8_LDB(B1, 0, 1); PG8_STAGE(PG8_SB(0, 0), b2, voffB);
            PG8_BAR; PG8_WAIT_L(0); PG8_MMA(0, 1, At, B1); PG8_BAR;
            PG8_LDA(At, 0, 1); PG8_STAGE(PG8_SA(0, 0), a2, voffA);
            PG8_BAR; PG8_WAIT_L(0); PG8_MMA(1, 0, At, B0); PG8_BAR; PG8_SCHED;
            PG8_STAGE(PG8_SB(0, 1), b2 + hstepB, voffB);
            PG8_WAIT_V(6); PG8_BAR; PG8_MMA(1, 1, At, B1); PG8_BAR;
            PG8_LDB(B0, 1, 0); PG8_SCHED; PG8_LDA(At, 1, 0); PG8_STAGE(PG8_SA(0, 1), a2 + hstepA, voffA);
            PG8_WAIT_L(8); PG8_BAR; PG8_WAIT_L(0); PG8_MMA(0, 0, At, B0); PG8_BAR; PG8_SCHED;
            PG8_LDB(B1, 1, 1); PG8_STAGE(PG8_SB(1, 0), b3, voffB);
            PG8_BAR; PG8_WAIT_L(0); PG8_MMA(0, 1, At, B1); PG8_BAR;
            PG8_LDA(At, 1, 1); PG8_STAGE(PG8_SA(1, 0), a3, voffA);
            PG8_BAR; PG8_WAIT_L(0); PG8_MMA(1, 0, At, B0); PG8_BAR; PG8_SCHED;
            PG8_STAGE(PG8_SB(1, 1), b3 + hstepB, voffB);
            PG8_WAIT_V(6); PG8_BAR; PG8_MMA(1, 1, At, B1); PG8_BAR;
            }
        }
        if constexpr (ALIGN_EPI) { if (wr == 0) PG8_BAR; }
        if constexpr (!Epi::AFTER_DRAIN) { E(acc, cur, wr, wc, fr, fq, rstdL); }
        if (!has_next) break;
#pragma unroll
        for (int a = 0; a < 2; ++a)
#pragma unroll
            for (int b = 0; b < 2; ++b)
#pragma unroll
                for (int m = 0; m < 4; ++m)
#pragma unroll
                    for (int n = 0; n < 2; ++n) acc[a][b][m][n] = (f32x4){0.f, 0.f, 0.f, 0.f};
        cur = nxt; cA = nA; cB = nB; ++ui;
        if constexpr (ALIGN_EPI) { if (wr == 1) PG8_BAR; }
    }
    u32x4 pre[4][2];
    if constexpr (Epi::AFTER_DRAIN) E.prefetch(pre, cur, wr, wc, fr, fq);
    PG8_WAIT_V(0);
    if constexpr (!ALIGN_EPI) { if (wr == 0) PG8_BAR; }
    PG8_BAR;
    if constexpr (Epi::AFTER_DRAIN) { E.fused(acc, pre, cur, wr, wc, fr, fq, lds, wid, lane); }
#undef PG8_SA
#undef PG8_SB
#undef PG8_STAGE
#undef PG8_LDA
#undef PG8_LDB
#undef PG8_MMA
#undef PG8_WAIT_V
#undef PG8_WAIT_L
#undef PG8_BAR
#undef PG8_SCHED
}
}
namespace att {
using bf16x8 = __attribute__((ext_vector_type(8))) short;
using s16x4 = __attribute__((ext_vector_type(4))) short;
using f32x16 = __attribute__((ext_vector_type(16))) float;
using f32x4 = __attribute__((ext_vector_type(4))) float;
using u32x4 = __attribute__((ext_vector_type(4))) unsigned;
typedef unsigned short bf16_t;
#define ATT_LAS __attribute__((address_space(3)))
constexpr int DM = 1024, SEQ = 2048, D = 64, NW = 8, QBLK = 32, QB = 256, KVBLK = 64;
constexpr int NSLOT = 3, SLOTB = 8192;
constexpr int L_K = 0, L_V = NSLOT * SLOTB, L_WS = 2 * NSLOT * SLOTB, L_OST = L_WS + NW * 256, L_QN = L_OST + NW * 4096, L_END = L_QN + NW * 4096;
constexpr int L_TAB = 134144, TABSZ = 1312;
constexpr int TABN = 320;
constexpr int TABR = 324;
constexpr float THR = 8.0f;
__device__ __forceinline__ int crow(int r, int hi) { return (r & 3) + 8 * (r >> 2) + 4 * hi; }
#define ASBAR() __builtin_amdgcn_sched_barrier(0)
__device__ __forceinline__ void glds16(const void* gsrc, unsigned lds_dst) { unsigned keep;
    asm volatile("s_mov_b32 %0, m0\n\ts_mov_b32 m0, %2\n\ts_nop 0\n\tglobal_load_lds_dwordx4 %1, off\n\ts_mov_b32 m0, %0" : "=&s"(keep) : "v"(gsrc), "s"(lds_dst) : "memory"); }
__device__ __forceinline__ unsigned cvtpk(float lo, float hi) { unsigned r; asm volatile("v_cvt_pk_bf16_f32 %0, %1, %2" : "=v"(r) : "v"(lo), "v"(hi)); return r; }
#define ATT_WAIT_BAR(N) asm volatile("s_waitcnt vmcnt(" #N ") lgkmcnt(0)\n\ts_barrier" ::: "memory")

__device__ __forceinline__ void vread16(s16x4* lo, s16x4* hi, int vb) {
#pragma unroll
    for (int d0 = 0; d0 < 2; ++d0)
#pragma unroll
        for (int ks = 0; ks < 4; ++ks) {
            asm volatile("ds_read_b64_tr_b16 %0,%1 offset:%c2" : "=&v"(lo[4 * d0 + ks]) : "v"(vb), "i"(d0 * 4096 + ks * 1024) : "memory");
            asm volatile("ds_read_b64_tr_b16 %0,%1 offset:%c2" : "=&v"(hi[4 * d0 + ks]) : "v"(vb), "i"(d0 * 4096 + ks * 1024 + 512) : "memory"); }
}
__device__ __forceinline__ void pv16(f32x16* o, const s16x4* lo, const s16x4* hi, bf16x8 pa0, bf16x8 pa1, bf16x8 pa2, bf16x8 pa3) {
#define ATT_PK(k) (bf16x8){lo[k][0], lo[k][1], lo[k][2], lo[k][3], hi[k][0], hi[k][1], hi[k][2], hi[k][3]}
    o[0] = __builtin_amdgcn_mfma_f32_32x32x16_bf16(pa0, ATT_PK(0), o[0], 0, 0, 0); o[1] = __builtin_amdgcn_mfma_f32_32x32x16_bf16(pa0, ATT_PK(4), o[1], 0, 0, 0);
    o[0] = __builtin_amdgcn_mfma_f32_32x32x16_bf16(pa1, ATT_PK(1), o[0], 0, 0, 0); o[1] = __builtin_amdgcn_mfma_f32_32x32x16_bf16(pa1, ATT_PK(5), o[1], 0, 0, 0);
    o[0] = __builtin_amdgcn_mfma_f32_32x32x16_bf16(pa2, ATT_PK(2), o[0], 0, 0, 0); o[1] = __builtin_amdgcn_mfma_f32_32x32x16_bf16(pa2, ATT_PK(6), o[1], 0, 0, 0);
    o[0] = __builtin_amdgcn_mfma_f32_32x32x16_bf16(pa3, ATT_PK(3), o[0], 0, 0, 0); o[1] = __builtin_amdgcn_mfma_f32_32x32x16_bf16(pa3, ATT_PK(7), o[1], 0, 0, 0);
#undef ATT_PK
}
__device__ __forceinline__ float rowmax32(const f32x16& p0, const f32x16& p1) {
    float a = fmaxf(p0[0], p1[0]);
#pragma unroll
    for (int r = 1; r < 16; ++r) a = fmaxf(a, fmaxf(p0[r], p1[r]));
    auto rr = __builtin_amdgcn_permlane32_swap(__float_as_uint(a), __float_as_uint(a), false, false);
    return fmaxf(__uint_as_float(rr[0]), __uint_as_float(rr[1]));
}

__device__ __forceinline__ void attn_tables(const float* tab, ATT_LAS unsigned char* shm, int wave) {
    const int tid = pg8::tid_of(wave); ATT_LAS float* tabL = (ATT_LAS float*)(shm + L_TAB);
    for (int idx = tid; idx < 4 * 4 * TABR; idx += NW * 64) { const int u_ = idx / (4 * TABR), r_ = idx % (4 * TABR), s_ = r_ / TABR, k_ = r_ % TABR - s_;
        tabL[u_ * TABSZ + r_] = (k_ >= 0 && k_ < TABN) ? tab[u_ * TABN + TABN - 1 - k_] : 0.f; }
}
__device__ __forceinline__ void attn_stream(int b, int qb, int h0, unsigned char* big, ATT_LAS unsigned char* shm, int wave) {
    int tid_ = pg8::tid_of(wave); asm volatile("" : "+v"(tid_));
    const int tid = tid_, lane = tid & 63, r32 = lane & 31, hi = lane >> 5; const int wid = __builtin_amdgcn_readfirstlane(tid >> 6);
    const int ci = wid >> 1;
    ATT_LAS float* wsf = (ATT_LAS float*)(shm + L_WS) + wid * 64;
    const long koffl = (long)h0 * pg8::KT + (long)lane * D + wid * 8, voffl = (long)h0 * pg8::KT + (long)(16 * (wid & 3) + (lane >> 2)) * D + (wid >> 2) * 32 + (lane & 3) * 8;
    const unsigned lds0 = (unsigned)(uintptr_t)shm;
    const unsigned kdst = lds0 + L_K + wid * 1024, vdst = lds0 + L_V + wid * 1024;
#define ATT_DMA_C(c_, u_, slotoff) do { const unsigned char* pan_ = big + (size_t)(b * 8 + ((c_) >> 2)) * pg8::PANEL_BYTES; const long ro_ = (long)(((c_) & 3) * KVBLK) * D + (long)(u_) * pg8::KT; \
        glds16((const bf16_t*)(pan_ + pg8::PO_K) + ro_ + koffl, (unsigned)__builtin_amdgcn_readfirstlane(kdst + (slotoff))); \
        glds16((const bf16_t*)(pan_ + pg8::PO_V) + ro_ + voffl, (unsigned)__builtin_amdgcn_readfirstlane(vdst + (slotoff))); } while (0)
#define ATT_LOADQ(u_) do { const bf16_t* qp_ = (const bf16_t*)(big + (size_t)(b * 8 + qb) * pg8::PANEL_BYTES + pg8::PO_Q) + (long)(h0 + (u_)) * pg8::KT + (long)(wid * QBLK) * D + lane * 8; \
        _Pragma("unroll") for (int i_ = 0; i_ < 4; ++i_) glds16(qp_ + i_ * 512, (unsigned)__builtin_amdgcn_readfirstlane(lds0 + L_QN + wid * 4096 + i_ * 1024)); } while (0)
    const int vb0 = (int)(lds0 + L_V) + ((lane >> 4) & 1) * 32 + (lane & 3) * 8 + (4 * hi + ((lane & 15) >> 2)) * 64;
    const int qi = (wid & 1) * 32 + r32;
    const int sj = (qi + 1) & 3, jb = 191 - qi + 4 * hi + sj;
    const int cs = (4 * qb - 8) > 0 ? (4 * qb - 8) : 0, NT = 4 * qb + 4 - cs, cq = 4 * qb + ci, t_lo = ((cq - 8) > 0 ? (cq - 8) : 0) - cs, t_hi = cq - cs;
    const int Gtot = 4 * NT;
    bf16x8 qr[4];
#pragma unroll
    for (int d0 = 0; d0 < 4; ++d0) qr[d0] = bf16x8{};
    ATT_LOADQ(0);
    int du = 0, dt = 0;
#define ATT_DMA_NEXT(slotoff) do { ATT_DMA_C(cs + dt, du, slotoff); if (++dt == NT) { ++du; dt = 0; } } while (0)
    ATT_DMA_NEXT(0); ATT_DMA_NEXT(SLOTB);
    int u = 0, t = 0;
    float mhat = 0.f, l_reg = 0.f, cfar = 0.f; f32x16 o[2]; o[0] = f32x16{}; o[1] = f32x16{};
    bool need_q = false, qwait = false;
    int slot = 0;
    for (int g = 0; g < Gtot; ++g) {
        if (g + 1 < Gtot) { if (qwait) { ATT_WAIT_BAR(6); } else { ATT_WAIT_BAR(2); } } else { ATT_WAIT_BAR(0); }
        qwait = false;
        if (g + 2 < Gtot) { const int s2 = (slot >= SLOTB) ? slot - SLOTB : slot + 2 * SLOTB; ATT_DMA_NEXT(s2); }
        if (need_q) { need_q = false; qwait = true; ATT_LOADQ(u + 1); }
        if (t >= t_lo && t <= t_hi) {
            const int dc = t_hi - t;
            const ATT_LAS float* tabL = (const ATT_LAS float*)(shm + L_TAB) + u * TABSZ;
            s16x4 vlo[8], vhi[8];
            vread16(vlo, vhi, vb0 + slot);
            bf16x8 kf[8];
            { const ATT_LAS unsigned char* kb = shm + L_K + slot + hi * 1024 + r32 * 16;
#pragma unroll
              for (int d0 = 0; d0 < 4; ++d0) { kf[2 * d0] = *reinterpret_cast<const ATT_LAS bf16x8*>(kb + d0 * 2048); kf[2 * d0 + 1] = *reinterpret_cast<const ATT_LAS bf16x8*>(kb + d0 * 2048 + 512); } }
            if (t == t_lo) { mhat = 0.f; l_reg = 0.f; o[0] = f32x16{}; o[1] = f32x16{};
                const ATT_LAS unsigned char* qn = shm + L_QN + wid * 4096 + r32 * 128 + hi * 16;
#pragma unroll
                for (int d0 = 0; d0 < 4; ++d0) qr[d0] = *reinterpret_cast<const ATT_LAS bf16x8*>(qn + d0 * 32);
                cfar = tabL[0];
                need_q = (u + 1 < 4); }
            f32x16 p0, p1;
            if (dc >= 3) {
                asm volatile("s_waitcnt lgkmcnt(0)" ::: "memory"); ASBAR();
#pragma unroll
                for (int r = 0; r < 16; ++r) { p0[r] = cfar - mhat; p1[r] = cfar - mhat; }
#pragma unroll
                for (int d0 = 0; d0 < 4; ++d0) { p0 = __builtin_amdgcn_mfma_f32_32x32x16_bf16(kf[2 * d0], qr[d0], p0, 0, 0, 0); p1 = __builtin_amdgcn_mfma_f32_32x32x16_bf16(kf[2 * d0 + 1], qr[d0], p1, 0, 0, 0); }
            } else {
                const ATT_LAS float* tb = tabL + sj * TABR + (jb - 64 * dc);
                f32x4 b0[4], b1[4];
#pragma unroll
                for (int g4 = 0; g4 < 4; ++g4) { b0[g4] = *(const ATT_LAS f32x4*)(tb + 8 * g4); b1[g4] = *(const ATT_LAS f32x4*)(tb + 32 + 8 * g4); }
                asm volatile("s_waitcnt lgkmcnt(0)" ::: "memory"); ASBAR();
#pragma unroll
                for (int r = 0; r < 16; ++r) { p0[r] = b0[r >> 2][r & 3] - mhat; p1[r] = b1[r >> 2][r & 3] - mhat; }
#pragma unroll
                for (int d0 = 0; d0 < 4; ++d0) { p0 = __builtin_amdgcn_mfma_f32_32x32x16_bf16(kf[2 * d0], qr[d0], p0, 0, 0, 0); p1 = __builtin_amdgcn_mfma_f32_32x32x16_bf16(kf[2 * d0 + 1], qr[d0], p1, 0, 0, 0); }
            }
            const float rm = rowmax32(p0, p1);
            if (t == t_lo) {
                mhat = rm;
#pragma unroll
                for (int r = 0; r < 16; ++r) { p0[r] -= rm; p1[r] -= rm; }
            } else if (__any(rm > THR)) {
                const float dl = fmaxf(rm, 0.f); mhat += dl;
#pragma unroll
                for (int r = 0; r < 16; ++r) { p0[r] -= dl; p1[r] -= dl; }
                const float f = __builtin_amdgcn_exp2f(-dl); l_reg *= f;
                if (hi == 0) wsf[r32] = f;
                asm volatile("s_waitcnt lgkmcnt(0)" ::: "memory");
#pragma unroll
                for (int g4 = 0; g4 < 4; ++g4) { const f32x4 fv = *(const ATT_LAS f32x4*)(wsf + 8 * g4 + 4 * hi);
#pragma unroll
                    for (int i = 0; i < 4; ++i) { o[0][4 * g4 + i] *= fv[i]; o[1][4 * g4 + i] *= fv[i]; } }
            }
            float sacc = 0.f;
#pragma unroll
            for (int r = 0; r < 16; ++r) { p0[r] = __builtin_amdgcn_exp2f(p0[r]); p1[r] = __builtin_amdgcn_exp2f(p1[r]); sacc += p0[r] + p1[r]; }
            l_reg += sacc;
            u32x4 pw0, pw1, pw2, pw3;
            pw0 = (u32x4){cvtpk(p0[0], p0[1]), cvtpk(p0[2], p0[3]), cvtpk(p0[4], p0[5]), cvtpk(p0[6], p0[7])};
            pw1 = (u32x4){cvtpk(p0[8], p0[9]), cvtpk(p0[10], p0[11]), cvtpk(p0[12], p0[13]), cvtpk(p0[14], p0[15])};
            pw2 = (u32x4){cvtpk(p1[0], p1[1]), cvtpk(p1[2], p1[3]), cvtpk(p1[4], p1[5]), cvtpk(p1[6], p1[7])};
            pw3 = (u32x4){cvtpk(p1[8], p1[9]), cvtpk(p1[10], p1[11]), cvtpk(p1[12], p1[13]), cvtpk(p1[14], p1[15])};
            ASBAR();
            pv16(o, vlo, vhi, __builtin_bit_cast(bf16x8, pw0), __builtin_bit_cast(bf16x8, pw1), __builtin_bit_cast(bf16x8, pw2), __builtin_bit_cast(bf16x8, pw3));
            if (t == t_hi) {
                { auto rr = __builtin_amdgcn_permlane32_swap(__float_as_uint(l_reg), __float_as_uint(l_reg), false, false); l_reg = __uint_as_float(rr[0]) + __uint_as_float(rr[1]); }
                if (hi == 0) wsf[32 + r32] = l_reg;
                asm volatile("s_waitcnt lgkmcnt(0)" ::: "memory");
                float rli[16];
#pragma unroll
                for (int g4 = 0; g4 < 4; ++g4) { const f32x4 lv = *(const ATT_LAS f32x4*)(wsf + 32 + 8 * g4 + 4 * hi);
#pragma unroll
                    for (int i = 0; i < 4; ++i) rli[4 * g4 + i] = __builtin_amdgcn_rcpf(lv[i]); }
                bf16_t* Ow = (bf16_t*)(big + (size_t)(b * 8 + qb) * pg8::PANEL_BYTES + pg8::PO_O) + (long)(h0 + u) * pg8::KT + (long)(wid * QBLK) * D;
                ATT_LAS bf16_t* stg = (ATT_LAS bf16_t*)(shm + L_OST) + wid * 2048;
#pragma unroll
                for (int r = 0; r < 16; ++r) { const int orow = crow(r, hi);
#pragma unroll
                    for (int d0 = 0; d0 < 2; ++d0) { const float v = o[d0][r] * rli[r]; const unsigned pk = cvtpk(v, v); stg[orow * 64 + d0 * 32 + r32] = (bf16_t)(pk & 0xffffu); } }
                asm volatile("s_waitcnt lgkmcnt(0)" ::: "memory");
#pragma unroll
                for (int i = 0; i < 4; ++i) { const int row = i * 8 + (lane >> 3), ch = lane & 7; const u32x4 v = *(const ATT_LAS u32x4*)(stg + row * 64 + ch * 8); *(u32x4*)(Ow + (long)row * D + ch * 8) = v; }
            }
        }
        slot = (slot == 2 * SLOTB) ? 0 : slot + SLOTB;
        if (++t == NT) { ++u; t = 0; }
    }
    asm volatile("s_waitcnt lgkmcnt(0)\n\ts_barrier" ::: "memory");
#undef ATT_DMA_C
#undef ATT_LOADQ
#undef ATT_DMA_NEXT
}
#undef ASBAR
}
constexpr int NWAVES = 8;
constexpr int BATCH = 8, SEQ = 2048, DM = 1024, NH = 16, FF = 4096, TOK = BATCH * SEQ, DEPTH = 4;
constexpr size_t MiB = 1u << 20;
constexpr size_t WS_CTL = 0, CTL_ZERO_BYTES = 1 * MiB;
constexpr size_t WS_TEXT = 1 * MiB;
constexpr size_t WS_GC = 1 * MiB + 64 * 1024;
constexpr size_t WS_SSQ = 1 * MiB + 256 * 1024;
constexpr size_t WS_ARENA = 2 * MiB, ARENA_BYTES = 24 * MiB;
constexpr size_t AR_MIX = 0, AR_WO = 6 * MiB, AR_WG = 4 * MiB, AR_W1 = 8 * MiB, AR_W2 = 16 * MiB;
constexpr size_t WS_HB = 50 * MiB;
constexpr size_t WS_BIG = 82 * MiB;
constexpr size_t WS_END = WS_BIG + 64 * pg8::PANEL_BYTES;
static_assert(WS_END <= 256 * MiB, "d_ws map");
constexpr int CW_BAR = 4096;

constexpr int RING_OFF = 0, RING_BYTES = 131072;
constexpr int LDSCTL_OFF = RING_BYTES, MISC_OFF = LDSCTL_OFF + 320;
constexpr int LDS_BYTES = 163840;
static_assert(att::L_END <= RING_BYTES, "attention scratch fits the ring region");

#define GAS __attribute__((address_space(1)))
#define LAS __attribute__((address_space(3)))
typedef unsigned short bf16;
typedef unsigned v4u __attribute__((ext_vector_type(4)));
typedef float f32x4 __attribute__((ext_vector_type(4)));
typedef GAS unsigned gu32;
#define RLX_AGENT __ATOMIC_RELAXED, __HIP_MEMORY_SCOPE_AGENT
#define LDS_WAIT() asm volatile("s_waitcnt lgkmcnt(0)" ::: "memory")
#define VM_WAIT() asm volatile("s_waitcnt vmcnt(0)" ::: "memory")
__device__ __forceinline__ unsigned f2bf(float f) { unsigned u = __builtin_bit_cast(unsigned, f); return (u + 0x7fffu + ((u >> 16) & 1u)) >> 16; }
__device__ __forceinline__ unsigned pk2(float lo, float hi) { return f2bf(lo) | (f2bf(hi) << 16); }

#define XB_TMO      128
#define XB_XCNT(j)  (256  + 64 * (j))
#define XB_XSUB(j)  (1280 + 64 * (j))
#define XB_XGEN(j)  (2304 + 64 * (j))
#define XB_TOP      3328
#define XB_TOPGEN   3392
#define XCD_BAR_WORDS 3456
#define XB_SPIN_CAP (1u << 18)
__device__ __forceinline__ unsigned xb_ld(unsigned* p)              { return __hip_atomic_load(p, __ATOMIC_RELAXED, __HIP_MEMORY_SCOPE_AGENT); }
__device__ __forceinline__ unsigned xb_add(unsigned* p, unsigned v) { return __hip_atomic_fetch_add(p, v, __ATOMIC_RELAXED, __HIP_MEMORY_SCOPE_AGENT); }
__device__ __forceinline__ unsigned xb_xcc_id() { return (unsigned)__builtin_amdgcn_s_getreg((3 << 11) | 20) & 0xFu; }
#define XB_SPIN(cond, bar) do { unsigned _sp = 0; while (cond) { __builtin_amdgcn_s_sleep(1); \
    if ((++_sp & 255u) == 0u) { if (xb_ld(&(bar)[XB_TMO])) break; if (_sp > XB_SPIN_CAP) { atomicAdd(&(bar)[XB_TMO], 1u); break; } } } } while (0)
struct XcdBarrier { unsigned* bar; unsigned x; volatile LAS unsigned* st; };
__device__ __forceinline__ XcdBarrier xcd_barrier_post(unsigned* bar, volatile LAS unsigned* st) {
    XcdBarrier b; b.bar = bar; b.x = xb_xcc_id(); b.st = st;
    if (threadIdx.x == 0) (void)xb_add(&bar[XB_XCNT(b.x)], 1u);
    return b;
}
__device__ __forceinline__ void xcd_barrier_complete(unsigned* bar, unsigned x, unsigned& nloc, unsigned& nx) {
    const unsigned G = gridDim.x * gridDim.y * gridDim.z;
    unsigned sum, cnt, mine, sp = 0u;
    for (;;) {
        sum = 0u; cnt = 0u; mine = 0u;
#pragma unroll
        for (unsigned j = 0; j < 16; ++j) { const unsigned c = xb_ld(&bar[XB_XCNT(j)]); sum += c; cnt += (c > 0u) ? 1u : 0u; mine = (j == x) ? c : mine; }
        if (sum == G) break;
        __builtin_amdgcn_s_sleep(1);
        if ((++sp & 255u) == 0u) { if (xb_ld(&bar[XB_TMO])) break; if (sp > XB_SPIN_CAP) { atomicAdd(&bar[XB_TMO], 1u); break; } }
    }
    nloc = mine > 0u ? mine : 1u; nx = cnt > 0u ? cnt : 1u;
}
__device__ __forceinline__ void xcd_barrier(const XcdBarrier& b, int wave) {
    asm volatile("s_waitcnt vmcnt(0)" ::: "memory");
    __syncthreads();
    if (pg8::tid_of(wave) == 0) {
        unsigned* bar = b.bar;
        __builtin_amdgcn_s_waitcnt(0);
        unsigned nloc = b.st[0], nx = b.st[1];
        if (nloc == 0u) { xcd_barrier_complete(bar, b.x, nloc, nx); b.st[0] = nloc; b.st[1] = nx; }
        const unsigned old = xb_add(&bar[XB_XSUB(b.x)], 1u);
        const unsigned gen = old / nloc;
        if (old + 1u == (gen + 1u) * nloc) {
            __builtin_amdgcn_fence(__ATOMIC_RELEASE, "agent");
            asm volatile("s_waitcnt vmcnt(0)" ::: "memory");
            const unsigned og = xb_add(&bar[XB_TOP], 1u);
            const unsigned tg = og / nx;
            if (og + 1u == (tg + 1u) * nx) xb_add(&bar[XB_TOPGEN], 1u);
            else XB_SPIN(xb_ld(&bar[XB_TOPGEN]) == tg, bar);
            __builtin_amdgcn_fence(__ATOMIC_ACQUIRE, "agent");
            xb_add(&bar[XB_XGEN(b.x)], 1u);
            asm volatile("s_waitcnt vmcnt(0)" ::: "memory");
        } else {
            XB_SPIN(xb_ld(&bar[XB_XGEN(b.x)]) == gen, bar);
            __builtin_amdgcn_fence(__ATOMIC_ACQUIRE, "agent");
            asm volatile("s_waitcnt vmcnt(0)" ::: "memory");
        }
    }
    __syncthreads();
}


#define GB_BASE(g)    (8192 + 1024 * (g))
#define GB_CEN(x)     (16 * (x))
#define GB_SUB(x)     (256 + 16 * (x))
#define GB_GEN(x)     (512 + 16 * (x))
#define GB_TOP        768
#define GB_TOPGEN     784
#define GB_SPIN(cond) do { unsigned _sp = 0; while (cond) { __builtin_amdgcn_s_sleep(1); if (++_sp > (1u << 22)) break; } } while (0)
__device__ __forceinline__ void group_barrier_post(unsigned* ctl, unsigned group) {
    if (threadIdx.x == 0) (void)xb_add(&ctl[GB_BASE(group) + GB_CEN(xb_xcc_id())], 1u);
}
#define GB_EVT        800
__device__ __forceinline__ void group_barrier(unsigned* ctl, unsigned group, volatile LAS unsigned* st, int wave, int dep0 = -1, int dep1 = -1, int delta = 0) {
    asm volatile("s_waitcnt vmcnt(0)" ::: "memory");
    __syncthreads();
    if (pg8::tid_of(wave) == 0) {
        unsigned* w = ctl + GB_BASE(group); const unsigned x = xb_xcc_id();
        __builtin_amdgcn_s_waitcnt(0);
        unsigned nloc = st[0], nx = st[1];
        if (nloc == 0u) { nx = 0u;
#pragma unroll
            for (unsigned j = 0; j < 16; ++j) { const unsigned c = xb_ld(&w[GB_CEN(j)]); nx += (c > 0u) ? 1u : 0u; nloc = (j == x) ? c : nloc; }
            nloc = nloc > 0u ? nloc : 1u; nx = nx > 0u ? nx : 1u; st[0] = nloc; st[1] = nx; }
        const unsigned ord = st[2] + 1u; st[2] = ord;
        const unsigned old = xb_add(&w[GB_SUB(x)], 1u);
        const unsigned gen = old / nloc;
        if (old + 1u == (gen + 1u) * nloc) {
            if (nx > 1u) {
                __builtin_amdgcn_fence(__ATOMIC_RELEASE, "agent");
                asm volatile("s_waitcnt vmcnt(0)" ::: "memory");
                const unsigned og = xb_add(&w[GB_TOP], 1u);
                const unsigned tg = og / nx;
                if (og + 1u == (tg + 1u) * nx) { xb_add(&w[GB_EVT], 1u); xb_add(&w[GB_TOPGEN], 1u); }
                else GB_SPIN(xb_ld(&w[GB_TOPGEN]) == tg);
            } else {
                xb_add(&w[GB_EVT], 1u);
            }
            if (dep0 >= 0) GB_SPIN((int)(xb_ld(&ctl[GB_BASE(dep0) + GB_EVT]) - (ord + (unsigned)delta)) < 0);
            if (dep1 >= 0) GB_SPIN((int)(xb_ld(&ctl[GB_BASE(dep1) + GB_EVT]) - (ord + (unsigned)delta)) < 0);
            __builtin_amdgcn_fence(__ATOMIC_ACQUIRE, "agent");
            xb_add(&w[GB_GEN(x)], 1u);
            asm volatile("s_waitcnt vmcnt(0)" ::: "memory");
        } else {
            GB_SPIN(xb_ld(&w[GB_GEN(x)]) == gen);
            if (dep0 >= 0) GB_SPIN((int)(xb_ld(&ctl[GB_BASE(dep0) + GB_EVT]) - (ord + (unsigned)delta)) < 0);
            if (dep1 >= 0) GB_SPIN((int)(xb_ld(&ctl[GB_BASE(dep1) + GB_EVT]) - (ord + (unsigned)delta)) < 0);
            __builtin_amdgcn_fence(__ATOMIC_ACQUIRE, "agent");
            asm volatile("s_waitcnt vmcnt(0)" ::: "memory");
        }
    }
    __syncthreads();
}
__device__ __forceinline__ bool label_one_xcc(unsigned* ctl, unsigned label) {
    unsigned nx = 0u;
#pragma unroll
    for (unsigned j = 0; j < 16; ++j) { const unsigned c = xb_ld(&ctl[GB_BASE(label) + GB_CEN(j)]); nx += (c > 0u) ? 1u : 0u; }
    return nx <= 1u;
}

__device__ __forceinline__ int opq_bx() { int b = blockIdx.x; asm volatile("" : "+s"(b)); return b; }
__device__ __forceinline__ int opq_i(int v) { asm volatile("" : "+s"(v)); return v; }
__device__ __forceinline__ unsigned char* opq_p(unsigned char* p) { unsigned long long a = (unsigned long long)p; asm volatile("" : "+s"(a)); return (unsigned char*)(GAS unsigned char*)a; }
__device__ __forceinline__ int opq_v(int v) { asm volatile("" : "+v"(v)); return v; }
struct Frame {
    LAS unsigned char* lds;
    volatile LAS unsigned* MISC;
    int tid, lane, wave, vcu, G;
    float* out; unsigned char* ws;
};
#define CAS __attribute__((address_space(4)))
__device__ __forceinline__ const float* inp(int i) {
    const CAS char* ka = (const CAS char*)__builtin_amdgcn_kernarg_segment_ptr(); asm volatile("" : "+s"(ka));
    const GAS float* p = *(const GAS float* const CAS*)(ka + 8 * i);
    return (const float*)p;
}
__device__ __forceinline__ float wave_sum(float v) {
    v += __int_as_float(__builtin_amdgcn_ds_swizzle(__float_as_int(v), 0x041F));
    v += __int_as_float(__builtin_amdgcn_ds_swizzle(__float_as_int(v), 0x081F));
    v += __int_as_float(__builtin_amdgcn_ds_swizzle(__float_as_int(v), 0x101F));
    v += __int_as_float(__builtin_amdgcn_ds_swizzle(__float_as_int(v), 0x201F));
    v += __int_as_float(__builtin_amdgcn_ds_swizzle(__float_as_int(v), 0x401F));
    const auto rr = __builtin_amdgcn_permlane32_swap(__float_as_uint(v), __float_as_uint(v), false, false);
    return __uint_as_float(rr[0]) + __uint_as_float(rr[1]);
}
__device__ __forceinline__ void transpose_item(const float* W, int N, bf16* WT, int ldo, const float* scale, LAS float* scr, int item, int nblk, int lane) {
    const int kb = item / nblk, nb = item % nblk, k0 = 64 * kb, n0 = 32 * nb;
    float v[32];
#pragma unroll
    for (int i = 0; i < 32; ++i) v[i] = __builtin_nontemporal_load(W + (size_t)(k0 + 2 * i + (lane >> 5)) * N + n0 + (lane & 31));
    if (scale) {
#pragma unroll
        for (int i = 0; i < 32; ++i) v[i] *= scale[k0 + 2 * i + (lane >> 5)]; }
#pragma unroll
    for (int i = 0; i < 32; ++i) scr[(2 * i + (lane >> 5)) * 33 + (lane & 31)] = v[i];
    LDS_WAIT(); asm volatile("" ::: "memory");
    const int c = lane & 7;
#pragma unroll
    for (int j = 0; j < 4; ++j) { const int n = (lane >> 3) + 8 * j; const LAS float* s = scr + (8 * c) * 33 + n;
        v4u o; o.x = pk2(s[0 * 33], s[1 * 33]); o.y = pk2(s[2 * 33], s[3 * 33]); o.z = pk2(s[4 * 33], s[5 * 33]); o.w = pk2(s[6 * 33], s[7 * 33]);
        *(GAS v4u*)(WT + (size_t)(n0 + n) * ldo + k0 + 8 * c) = o; }
    LDS_WAIT(); asm volatile("" ::: "memory");
}
__device__ __forceinline__ unsigned char* arena_of(Frame& F, int L) { return L < 2 ? (unsigned char*)F.out + (size_t)L * ARENA_BYTES : F.ws + WS_ARENA + (size_t)(L - 2) * ARENA_BYTES; }
constexpr int CI_W1 = (DM / 64) * (FF / 32), CI_W2 = (FF / 64) * (DM / 32);
constexpr int CI_ATT_A = (DM / 64) * (3 * DM / 32), CI_ATT_B = (DM / 64) * (DM / 32), CI_ATT = CI_ATT_A + CI_ATT_B + CI_W1 + CI_W2;
constexpr int CI_REC_A = (DM / 64) * (2 * DM / 32), CI_REC_G = 512, CI_REC_B = (DM / 64) * (DM / 32), CI_REC = CI_REC_A + CI_REC_G + CI_REC_B + CI_W1 + CI_W2;
struct ConvPtrs { const float *nmix, *nmlp, *wqkv, *wo, *win, *cw, *wga, *wgx, *wro, *w1, *w2; };
__device__ __forceinline__ void convert_item(Frame& F, const ConvPtrs& P, int L, int r, LAS float* scr) {
    const int j = L >> 1;
    unsigned char* ar = arena_of(F, L);
    const float* w1 = P.w1 + (size_t)L * DM * FF; const float* w2 = P.w2 + (size_t)L * FF * DM;
    const float* gmix = P.nmix + L * DM; const float* gmlp = P.nmlp + L * DM;
    if ((L & 1) == 0) {
        const float* wqkv = P.wqkv + (size_t)j * DM * 3 * DM; const float* wo = P.wo + (size_t)j * DM * DM;
        if (r < CI_ATT_A) { transpose_item(wqkv, 3 * DM, (bf16*)(ar + AR_MIX), DM, gmix, scr, r, 3 * DM / 32, F.lane); return; } r -= CI_ATT_A;
        if (r < CI_ATT_B) { transpose_item(wo, DM, (bf16*)(ar + AR_WO), DM, nullptr, scr, r, DM / 32, F.lane); return; } r -= CI_ATT_B;
    } else {
        const float* win = P.win + (size_t)j * DM * 2 * DM; const float* wro = P.wro + (size_t)j * DM * DM;
        const float* wga = P.wga + (size_t)j * 8 * 128 * 128; const float* wgx = P.wgx + (size_t)j * 8 * 128 * 128; const float* cw = P.cw + (size_t)j * 4 * DM;
        if (r < CI_REC_A) { transpose_item(win, 2 * DM, (bf16*)(ar + AR_MIX), DM, gmix, scr, r, 2 * DM / 32, F.lane); return; } r -= CI_REC_A;
        if (r < CI_REC_G) { const int sub = r & 7, q = r >> 3, tap = q & 3, gate = (q >> 2) & 1, n = q >> 3;
            transpose_item((gate ? wgx : wga) + (size_t)n * 128 * 128, 128, (bf16*)(ar + AR_WG) + (size_t)(n * 256 + gate * 128) * 512 + tap * 128, 512, cw + tap * DM + n * 128, scr, sub, 4, F.lane); return; } r -= CI_REC_G;
        if (r < CI_REC_B) { transpose_item(wro, DM, (bf16*)(ar + AR_WO), DM, nullptr, scr, r, DM / 32, F.lane); return; } r -= CI_REC_B;
    }
    if (r < CI_W1) { transpose_item(w1, FF, (bf16*)(ar + AR_W1), DM, gmlp, scr, r, FF / 32, F.lane); return; } r -= CI_W1;
    transpose_item(w2, DM, (bf16*)(ar + AR_W2), FF, nullptr, scr, r, DM / 32, F.lane);
}
__device__ __forceinline__ void convert_all(Frame& F) {
    LAS float* scr = (LAS float*)(F.lds + RING_OFF + F.wave * 16384);
    const int gw = F.vcu * NWAVES + F.wave, NGW = F.G * NWAVES;
    const ConvPtrs P{inp(1), inp(2), inp(3), inp(4), inp(6), inp(8), inp(10), inp(12), inp(15), inp(17), inp(18)};
    for (int it = gw; it < 2 * (CI_ATT + CI_REC); it += NGW) {
        const int pair = it / (CI_ATT + CI_REC), r = it % (CI_ATT + CI_REC);
        if (r < CI_ATT) convert_item(F, P, 2 * pair, r, scr); else convert_item(F, P, 2 * pair + 1, r - CI_ATT, scr);
    }
}
__device__ __forceinline__ void p0_prologue(Frame& F) {
    convert_all(F);
    const int gt = F.vcu * (NWAVES * 64) + F.tid;
    if (gt < 2 * NH * 320) {
        const int i = gt % 320, jh = gt / 320; const float* rel = inp(5);
        ((float*)(F.ws + WS_TEXT))[gt] = rel[(size_t)jh * 257 + (i < 256 ? i : 256)] * 1.4426950408889634f;
    } else if (gt >= 16384 && gt < 16384 + 2 * DM) {
        const int q = gt - 16384, j = q >> 10, ch = q & 1023, n = ch >> 7, e = ch & 127;
        const float* cb = inp(9) + j * DM; const float* cw = inp(8) + (size_t)j * 4 * DM;
        const float* wga = inp(10) + ((size_t)j * 8 + n) * 128 * 128; const float* wgx = inp(12) + ((size_t)j * 8 + n) * 128 * 128;
        float sa = inp(11)[j * DM + ch], sx = inp(13)[j * DM + ch];
        for (int c = 0; c < 128; ++c) { const float cv = cb[n * 128 + c]; sa += cv * wga[c * 128 + e]; sx += cv * wgx[c * 128 + e]; }
        const float Lp = inp(14)[j * DM + ch];
        float* g = (float*)(F.ws + WS_GC) + (size_t)q * 8;
        g[0] = sa; g[1] = sx; g[2] = cb[ch]; g[3] = -8.0f * log1pf(expf(-Lp)) * 1.4426950408889634f;
        g[4] = cw[ch]; g[5] = cw[DM + ch]; g[6] = cw[2 * DM + ch]; g[7] = cw[3 * DM + ch];
    }
    const int gw = F.vcu * NWAVES + F.wave, NGW = F.G * NWAVES;
    const float* x = inp(0); bf16* hb = (bf16*)(F.ws + WS_HB); float* ssq = (float*)(F.ws + WS_SSQ);
    for (int m = gw; m < TOK; m += NGW) {
        const GAS f32x4* xr = (const GAS f32x4*)(x + (size_t)m * DM) + F.lane;
        f32x4 v[4]; float s = 0.f;
#pragma unroll
        for (int jj = 0; jj < 4; ++jj) { v[jj] = xr[64 * jj]; s += (v[jj].x * v[jj].x + v[jj].y * v[jj].y) + (v[jj].z * v[jj].z + v[jj].w * v[jj].w); }
        s = wave_sum(s);
        bf16* hp = hb + (size_t)(m >> 8) * (256 * DM) + (size_t)(m & 255) * 64;
#pragma unroll
        for (int jj = 0; jj < 4; ++jj) *(GAS unsigned long long*)(hp + (size_t)((F.lane >> 4) + 4 * jj) * pg8::KT + 4 * (F.lane & 15)) = (unsigned long long)pk2(v[jj].x, v[jj].y) | ((unsigned long long)pk2(v[jj].z, v[jj].w) << 32);
        if (F.lane < 4) ssq[(size_t)F.lane * TOK + m] = (F.lane == 0) ? s : 0.f;
    }
}
__device__ __forceinline__ void final_norm(Frame& F) {
    const int gw = F.vcu * NWAVES + F.wave, NGW = F.G * NWAVES; const float* gf = inp(19); const bf16* hb = (const bf16*)(F.ws + WS_HB);
    f32x4 g[4];
#pragma unroll
    for (int jj = 0; jj < 2; ++jj) { g[2 * jj] = *(const f32x4*)(gf + 512 * jj + 8 * F.lane); g[2 * jj + 1] = *(const f32x4*)(gf + 512 * jj + 8 * F.lane + 4); }
    for (int m = gw; m < TOK; m += NGW) {
        f32x4 v[4]; float s = 0.f;
#pragma unroll
        for (int jj = 0; jj < 2; ++jj) { const v4u r = *(const GAS v4u*)(hb + (size_t)(m >> 8) * (256 * DM) + (size_t)((F.lane >> 3) + 8 * jj) * pg8::KT + (size_t)(m & 255) * 64 + 8 * (F.lane & 7));
            v[2 * jj] = (f32x4){pg8::bf_lo(r.x), pg8::bf_hi(r.x), pg8::bf_lo(r.y), pg8::bf_hi(r.y)}; v[2 * jj + 1] = (f32x4){pg8::bf_lo(r.z), pg8::bf_hi(r.z), pg8::bf_lo(r.w), pg8::bf_hi(r.w)}; }
#pragma unroll
        for (int q = 0; q < 4; ++q) s += (v[q].x * v[q].x + v[q].y * v[q].y) + (v[q].z * v[q].z + v[q].w * v[q].w);
        const float rstd = __builtin_amdgcn_rsqf(wave_sum(s) * (1.0f / DM) + 1e-6f);
#pragma unroll
        for (int jj = 0; jj < 2; ++jj) { GAS f32x4* o = (GAS f32x4*)(F.out + (size_t)m * DM + 512 * jj + 8 * F.lane); o[0] = v[2 * jj] * rstd * g[2 * jj]; o[1] = v[2 * jj + 1] * rstd * g[2 * jj + 1]; }
    }
}
__device__ __forceinline__ void scan_phase(Frame& F, unsigned char* big, const float* gc) {
    LAS float* sA = (LAS float*)(F.lds + RING_OFF);
    LAS float* sH = sA + 1024;
    LAS float* sC = sH + 1024;
    for (int item = opq_i(F.vcu); item < BATCH * 32; item += F.G) {
        const int tid = opq_v(pg8::tid_of(F.wave)); const int b = item >> 5, cg = item & 31, cp = tid & 15, seg = tid >> 4;
        const int ch = cg * 32 + 2 * cp;
        const f32x4 k0a = *(const f32x4*)(gc + (size_t)ch * 8), k0b = *(const f32x4*)(gc + (size_t)ch * 8 + 4), k1a = *(const f32x4*)(gc + (size_t)(ch + 1) * 8), k1b = *(const f32x4*)(gc + (size_t)(ch + 1) * 8 + 4);
        const float cb0 = k0a[2], cb1 = k1a[2];
        if (tid < 32) sC[tid] = 0.f;
#pragma unroll 1
        for (int hf = 0; hf < 2; ++hf) {
            const int t0 = hf * 1024 + seg * 32;
            const unsigned char* pan = big + (size_t)(b * 8 + (t0 >> 8)) * pg8::PANEL_BYTES;
            const size_t eo = (size_t)(ch >> 6) * pg8::KT + (size_t)(t0 & 255) * 64 + (ch & 63), eox = (size_t)(ch >> 6) * pg8::KTX + (size_t)(t0 & 255) * 64 + (ch & 63);
            const unsigned* pa = (const unsigned*)((const bf16*)(pan + pg8::PO_AL) + eo); const unsigned* pb = (const unsigned*)((const bf16*)(pan + pg8::PO_BQ) + eo);
            const unsigned* py = (const unsigned*)((const bf16*)(pan + pg8::PO_Y) + eo); const unsigned* px = (const unsigned*)((const bf16*)(pan + pg8::PO_X) + eox);
            unsigned ua[32], ub[32], uy[32], ux[35];
#pragma unroll
            for (int s = 0; s < 35; ++s) ux[s] = px[(size_t)s * 32];
#pragma unroll
            for (int s = 0; s < 32; ++s) { ua[s] = pa[(size_t)s * 32]; ub[s] = pb[(size_t)s * 32]; }
#pragma unroll
            for (int s = 0; s < 32; ++s) uy[s] = py[(size_t)s * 32];
            float A0 = 1.f, A1 = 1.f, H0 = 0.f, H1 = 0.f;
#pragma unroll
            for (int s = 0; s < 32; ++s) {
                const float a0 = __builtin_amdgcn_exp2f(pg8::bf_lo(ua[s])), a1 = __builtin_amdgcn_exp2f(pg8::bf_hi(ua[s]));
                const float xc0 = cb0 + k0b[0] * pg8::bf_lo(ux[s]) + k0b[1] * pg8::bf_lo(ux[s + 1]) + k0b[2] * pg8::bf_lo(ux[s + 2]) + k0b[3] * pg8::bf_lo(ux[s + 3]);
                const float xc1 = cb1 + k1b[0] * pg8::bf_hi(ux[s]) + k1b[1] * pg8::bf_hi(ux[s + 1]) + k1b[2] * pg8::bf_hi(ux[s + 2]) + k1b[3] * pg8::bf_hi(ux[s + 3]);
                H0 = a0 * H0 + pg8::bf_lo(ub[s]) * xc0; H1 = a1 * H1 + pg8::bf_hi(ub[s]) * xc1; A0 *= a0; A1 *= a1; }
            sA[seg * 32 + 2 * cp] = A0; sA[seg * 32 + 2 * cp + 1] = A1; sH[seg * 32 + 2 * cp] = H0; sH[seg * 32 + 2 * cp + 1] = H1;
            __syncthreads();
            float c0 = sC[2 * cp], c1 = sC[2 * cp + 1];
            for (int s2 = 0; s2 < seg; ++s2) { c0 = sA[s2 * 32 + 2 * cp] * c0 + sH[s2 * 32 + 2 * cp]; c1 = sA[s2 * 32 + 2 * cp + 1] * c1 + sH[s2 * 32 + 2 * cp + 1]; }
            unsigned* po = (unsigned*)((bf16*)(pan + pg8::PO_G) + eo);
#pragma unroll
            for (int s = 0; s < 32; ++s) {
                const float a0 = __builtin_amdgcn_exp2f(pg8::bf_lo(ua[s])), a1 = __builtin_amdgcn_exp2f(pg8::bf_hi(ua[s]));
                const float xc0 = cb0 + k0b[0] * pg8::bf_lo(ux[s]) + k0b[1] * pg8::bf_lo(ux[s + 1]) + k0b[2] * pg8::bf_lo(ux[s + 2]) + k0b[3] * pg8::bf_lo(ux[s + 3]);
                const float xc1 = cb1 + k1b[0] * pg8::bf_hi(ux[s]) + k1b[1] * pg8::bf_hi(ux[s + 1]) + k1b[2] * pg8::bf_hi(ux[s + 2]) + k1b[3] * pg8::bf_hi(ux[s + 3]);
                c0 = a0 * c0 + pg8::bf_lo(ub[s]) * xc0; c1 = a1 * c1 + pg8::bf_hi(ub[s]) * xc1;
                po[(size_t)s * 32] = pg8::cvt_pk_bf16(c0 * pg8::bf_lo(uy[s]), c1 * pg8::bf_hi(uy[s])); }
            __syncthreads();
            if (seg == 31) { sC[2 * cp] = c0; sC[2 * cp + 1] = c1; }
            __syncthreads();
        }
    }
}

struct Args { const float* in[20]; float* out; unsigned char* ws; int n_sub; int pad; };
__global__ void __launch_bounds__(NWAVES * 64, 2) mega_fwd(Args args) {
    extern __shared__ __attribute__((aligned(16))) unsigned char lds[];
    Frame F;
    F.lds = (LAS unsigned char*)lds;
    F.MISC = (volatile LAS unsigned*)(F.lds + MISC_OFF);
    F.tid = threadIdx.x; F.lane = F.tid & 63; F.wave = __builtin_amdgcn_readfirstlane(F.tid >> 6);
    F.G = gridDim.x; { const int bx = blockIdx.x; F.vcu = (F.G % 8 == 0) ? (bx % 8) * (F.G / 8) + bx / 8 : bx; }
    F.out = args.out; F.ws = args.ws;
    unsigned char* ws = args.ws;
    for (int u = F.tid; u < (LDS_BYTES - LDSCTL_OFF) / 4; u += NWAVES * 64) ((LAS unsigned*)(F.lds + LDSCTL_OFF))[u] = 0u;
    __syncthreads();
    XcdBarrier bar = xcd_barrier_post((unsigned*)(ws + WS_CTL) + CW_BAR, F.MISC + 8);
#define GRID_BAR() xcd_barrier(bar, F.wave)
    group_barrier_post((unsigned*)(ws + WS_CTL), blockIdx.x & 7u);
    group_barrier_post((unsigned*)(ws + WS_CTL), 8u + (blockIdx.x & 7u) * 8u + ((blockIdx.x >> 3) & 7u));
#define P_LABEL ((unsigned)opq_bx() & 7u)
#define P_QUAD (((unsigned)opq_bx() >> 3) & 7u)
#define QGROUP(p_) (8u + P_LABEL * 8u + (unsigned)(p_))
#define CTLW ((unsigned*)(ws_ + WS_CTL))
#define GROUP_BAR() group_barrier(CTLW, P_LABEL, F.MISC + 10, F.wave)
#define QUAD_BAR() group_barrier(CTLW, QGROUP(P_QUAD), F.MISC + 13, F.wave)
#define CAUSAL_BAR(D2) do { if (fastdf) { const int pq_ = (int)P_QUAD; group_barrier(CTLW, QGROUP(pq_), F.MISC + 13, F.wave, pq_ >= 1 ? (int)QGROUP(pq_ - 1) : -1, ((D2) && pq_ >= 2) ? (int)QGROUP(pq_ - 2) : -1, 0); } else GROUP_BAR(); } while (0)
#define QUADL_BAR() do { if (fastdf) QUAD_BAR(); else GROUP_BAR(); } while (0)
#define QUAD_BAR_WAR() do { if (fastdf) { const int pq_ = (int)P_QUAD; group_barrier(CTLW, QGROUP(pq_), F.MISC + 13, F.wave, pq_ + 1 < 8 ? (int)QGROUP(pq_ + 1) : -1, pq_ + 2 < 8 ? (int)QGROUP(pq_ + 2) : -1, -1); } else QUAD_BAR(); } while (0)


    p0_prologue(F);
    GRID_BAR();
    const int fast0 = __builtin_amdgcn_readfirstlane(label_one_xcc((unsigned*)(ws + WS_CTL), blockIdx.x & 7u) ? 1 : 0);

    const int n_sub = args.n_sub;
    for (int sub = 0; sub < n_sub; ++sub) {
        const int L = sub >> 1, j = L >> 1;
        F.vcu = opq_i(F.vcu);
        unsigned char* ws_ = opq_p(args.ws);
        bf16* HB = (bf16*)(ws_ + WS_HB); float* SSQ = (float*)(ws_ + WS_SSQ); unsigned char* BIG = ws_ + WS_BIG;
        unsigned char* ar = arena_of(F, L);
        const bool fastdf = fast0 != 0;
        pg8::Gemm gr; const float* rbias = nullptr; bool war = false;
        if ((sub & 1) == 0) {
            if ((L & 1) == 0) {
                { pg8::Gemm g{(const char*)HB, (size_t)256 * DM * 2, (const bf16*)(ar + AR_MIX), DM, 64, 32768}; pg8::StaticOrder S; S.init(TOK, 3 * DM, F.G, opq_bx());
                  pg8::EpiQKV E{BIG, SSQ};
                  pg8::gemm_phase<pg8::EpiQKV, 0, true, true>(F.lds + RING_OFF, g, S, E, F.wave); }
                CAUSAL_BAR(1);
                { const int h0 = (int)((unsigned)opq_bx() >> 6) * 4; const float* tab = (const float*)(ws_ + WS_TEXT) + ((size_t)j * NH + h0) * 320;
                  att::attn_tables(tab, F.lds + RING_OFF, F.wave);
                  att::attn_stream((int)P_LABEL, (int)P_QUAD, h0, BIG, F.lds + RING_OFF, F.wave); }
                QUADL_BAR();
                war = true;
                gr = pg8::Gemm{(const char*)(BIG + pg8::PO_O), pg8::PANEL_BYTES, (const bf16*)(ar + AR_WO), DM, 64, 32768};
            } else {
                if (opq_bx() < BATCH) { const int tz = pg8::tid_of(F.wave); if (tz < 384) { const unsigned z = (unsigned)opq_v(0);
                    *(GAS v4u*)((bf16*)(BIG + (size_t)(opq_bx() * 8) * pg8::PANEL_BYTES + pg8::PO_X) + (size_t)(tz / 24) * pg8::KTX + (tz % 24) * 8) = (v4u){z, z, z, z}; } }
                { pg8::Gemm g{(const char*)HB, (size_t)256 * DM * 2, (const bf16*)(ar + AR_MIX), DM, 64, 32768}; pg8::StaticOrder S; S.init(TOK, 2 * DM, F.G, opq_bx());
                  pg8::EpiIn E{BIG, SSQ, inp(7) + (size_t)j * 2 * DM};
                  pg8::gemm_phase<pg8::EpiIn, 0, true, true>(F.lds + RING_OFF, g, S, E, F.wave); }
                CAUSAL_BAR(0);
                { pg8::Gemm g{(const char*)(BIG + pg8::PO_X), pg8::PANEL_BYTES, (const bf16*)(ar + AR_WG), 512, 64, 0}; pg8::StaticOrder S; S.init(TOK, 2 * DM, F.G, opq_bx());
                  pg8::EpiGate E{BIG, (const float*)(ws_ + WS_GC) + (size_t)j * DM * 8};
                  pg8::gemm_phase<pg8::EpiGate, 1, true, true>(F.lds + RING_OFF, g, S, E, F.wave); }
                GROUP_BAR();
                scan_phase(F, BIG, (const float*)(ws_ + WS_GC) + (size_t)j * DM * 8);
                GROUP_BAR();
                gr = pg8::Gemm{(const char*)(BIG + pg8::PO_G), pg8::PANEL_BYTES, (const bf16*)(ar + AR_WO), DM, 64, 32768}; rbias = inp(16) + (size_t)j * DM;
            }
        } else {
            { pg8::Gemm g{(const char*)HB, (size_t)256 * DM * 2, (const bf16*)(ar + AR_W1), DM, 64, 32768}; pg8::StaticOrder S; S.init(TOK, FF, F.G, opq_bx());
              pg8::EpiUp E{BIG, SSQ};
              pg8::gemm_phase<pg8::EpiUp, 0, true, true>(F.lds + RING_OFF, g, S, E, F.wave); }
            QUAD_BAR();
            gr = pg8::Gemm{(const char*)(BIG + pg8::PO_Z), pg8::PANEL_BYTES, (const bf16*)(ar + AR_W2), FF, 64, 32768};
        }
        { pg8::StaticOrder S; S.init(TOK, DM, F.G, opq_bx());
          pg8::EpiRes E{HB, SSQ, rbias};
          pg8::gemm_phase<pg8::EpiRes, 0, false, true>(F.lds + RING_OFF, gr, S, E, F.wave); }
        if (war) QUAD_BAR_WAR(); else QUAD_BAR();
    }
    GRID_BAR();
    F.tid = pg8::tid_of(F.wave); F.lane = F.tid & 63;
    if (n_sub == 2 * DEPTH) { final_norm(F); }
}

#if FAST_SUBS < 8
namespace nv {
constexpr int D = 1024, B = 8, S = 2048, DEPTH = 4, H = 16, HD = 64, CH = 64, LEFT = 8, BAND = 9 * 64, MAXREL = 128, NREL = 257;
constexpr int DR = 1024, NB = 8, RB = 128, FF = 4096;

__global__ void rmsnorm_k(const float* x, const float* __restrict__ g, float* y) {
    const int row = blockIdx.x, tid = threadIdx.x;
    const float* xr = x + (size_t)row * D;
    float v[4], s = 0.f;
#pragma unroll
    for (int i = 0; i < 4; ++i) { v[i] = xr[tid + 256 * i]; s += v[i] * v[i]; }
    __shared__ float red[256];
    red[tid] = s; __syncthreads();
    for (int o = 128; o > 0; o >>= 1) { if (tid < o) red[tid] += red[tid + o]; __syncthreads(); }
    const float rstd = rsqrtf(red[0] / D + 1e-6f);
#pragma unroll
    for (int i = 0; i < 4; ++i) y[(size_t)row * D + tid + 256 * i] = v[i] * rstd * g[tid + 256 * i];
}

__global__ void gemm_k(const float* __restrict__ A, int lda, const float* __restrict__ Bm, int ldb, float* C, int ldc,
                       const float* __restrict__ bias, const float* res, int ldr, int K, int act) {
    __shared__ float As[16][64 + 1], Bs[16][64 + 1];
    const int tx = threadIdx.x & 15, ty = threadIdx.x >> 4, m0 = blockIdx.y * 64, n0 = blockIdx.x * 64;
    float acc[4][4] = {};
    for (int k0 = 0; k0 < K; k0 += 16) {
        for (int i = threadIdx.x; i < 64 * 16; i += 256) { const int r = i >> 4, c = i & 15; As[c][r] = A[(size_t)(m0 + r) * lda + k0 + c]; }
        for (int i = threadIdx.x; i < 16 * 64; i += 256) { const int r = i >> 6, c = i & 63; Bs[r][c] = Bm[(size_t)(k0 + r) * ldb + n0 + c]; }
        __syncthreads();
#pragma unroll
        for (int kk = 0; kk < 16; ++kk) {
            float a[4], b[4];
#pragma unroll
            for (int i = 0; i < 4; ++i) { a[i] = As[kk][ty * 4 + i]; b[i] = Bs[kk][tx * 4 + i]; }
#pragma unroll
            for (int i = 0; i < 4; ++i)
#pragma unroll
                for (int j = 0; j < 4; ++j) acc[i][j] += a[i] * b[j];
        }
        __syncthreads();
    }
#pragma unroll
    for (int i = 0; i < 4; ++i)
#pragma unroll
        for (int j = 0; j < 4; ++j) {
            const int r = m0 + ty * 4 + i, c = n0 + tx * 4 + j;
            float v = acc[i][j];
            if (bias) v += bias[c];
            if (act == 1) { v = fmaxf(v, 0.f); v = v * v; }
            if (res) v += res[(size_t)r * ldr + c];
            C[(size_t)r * ldc + c] = v;
        }
}

__global__ void __launch_bounds__(64) attn_k(const float* __restrict__ qkv, const float* __restrict__ table, float* __restrict__ o) {
    const int c = blockIdx.x, h = blockIdx.y, qi = threadIdx.x, t = c * CH + qi;
    float q[HD], acc[HD];
#pragma unroll
    for (int d = 0; d < HD; ++d) { q[d] = qkv[(size_t)t * 3 * D + h * HD + d]; acc[d] = 0.f; }
    const int k0 = c * CH - LEFT * CH;
    float m = -1e30f;
    for (int j = 0; j < BAND; ++j) {
        const int kp = k0 + j; if (kp < 0) continue;
        const float* kr = qkv + (size_t)kp * 3 * D + D + h * HD;
        float s = 0.f;
    #pragma unroll
    for (int d = 0; d < HD; ++d) s += q[d] * kr[d];
        int rel = t - kp; rel = rel < -MAXREL ? -MAXREL : (rel > MAXREL ? MAXREL : rel);
        s = s * 0.125f + table[h * NREL + rel + MAXREL];
        m = fmaxf(m, s);
    }
    float l = 0.f;
    for (int j = 0; j < BAND; ++j) {
        const int kp = k0 + j; if (kp < 0) continue;
        const float* kr = qkv + (size_t)kp * 3 * D + D + h * HD;
        const float* vr = qkv + (size_t)kp * 3 * D + 2 * D + h * HD;
        float s = 0.f;
    #pragma unroll
    for (int d = 0; d < HD; ++d) s += q[d] * kr[d];
        int rel = t - kp; rel = rel < -MAXREL ? -MAXREL : (rel > MAXREL ? MAXREL : rel);
        s = s * 0.125f + table[h * NREL + rel + MAXREL];
        const float p = expf(s - m);
        l += p;
    #pragma unroll
    for (int d = 0; d < HD; ++d) acc[d] += p * vr[d];
    }
    const float il = 1.f / l;
#pragma unroll
    for (int d = 0; d < HD; ++d) o[(size_t)t * D + h * HD + d] = acc[d] * il;
}

__global__ void conv_k(const float* __restrict__ u, const float* __restrict__ cw, const float* __restrict__ cb, float* __restrict__ xc) {
    const int t = blockIdx.x;
    for (int ch = threadIdx.x; ch < DR; ch += 256) {
        float v = cb[ch];
        for (int tap = 0; tap < 4; ++tap) { const int tt = t - 3 + tap; if (tt >= 0) v += u[(size_t)tt * 2 * DR + ch] * cw[tap * DR + ch]; }
        xc[(size_t)t * DR + ch] = v;
    }
}

__global__ void gates_k(const float* __restrict__ xc, const float* __restrict__ wga, const float* __restrict__ bga, const float* __restrict__ wgx,
                        const float* __restrict__ bgx, const float* __restrict__ ap, float* __restrict__ a, float* __restrict__ bq) {
    const int t = blockIdx.x;
    __shared__ float xr[DR];
    for (int i = threadIdx.x; i < DR; i += 256) xr[i] = xc[(size_t)t * DR + i];
    __syncthreads();
    for (int e = threadIdx.x; e < DR; e += 256) {
        const int n = e / RB, ee = e % RB;
        float sa = bga[e], sx = bgx[e];
        for (int c2 = 0; c2 < RB; ++c2) { const float xv = xr[n * RB + c2]; sa += xv * wga[((size_t)n * RB + c2) * RB + ee]; sx += xv * wgx[((size_t)n * RB + c2) * RB + ee]; }
        const float r = 1.f / (1.f + expf(-sa)), ig = 1.f / (1.f + expf(-sx));
        const float L = ap[e];
        const float sp = log1pf(expf(-L));
        const float log_a = -8.f * r * sp;
        const float av = expf(log_a);
        const float mult = sqrtf(-expm1f(2.f * log_a));
        a[(size_t)t * DR + e] = av;
        bq[(size_t)t * DR + e] = mult * (ig * xr[e]);
    }
}

__global__ void scan_k(const float* __restrict__ a, const float* __restrict__ bq, const float* __restrict__ u, float* __restrict__ out) {
    const int ch = blockIdx.x * blockDim.x + threadIdx.x;
    float hs = 0.f;
    for (int t = 0; t < S; ++t) {
        hs = a[(size_t)t * DR + ch] * hs + bq[(size_t)t * DR + ch];
        const float y = u[(size_t)t * 2 * DR + DR + ch];
        const float gy = 0.5f * y * (1.f + tanhf(0.7978845608028654f * (y + 0.044715f * y * y * y)));
        out[(size_t)t * DR + ch] = hs * gy;
    }
}
}
#endif
#if FAST_SUBS < 8
__global__ void dbg_bf2f(const unsigned short* in, float* out, size_t n) { for (size_t i = (size_t)blockIdx.x * blockDim.x + threadIdx.x; i < n; i += (size_t)gridDim.x * blockDim.x) { const size_t m = i >> 10, c = i & 1023; out[i] = __uint_as_float((unsigned)in[(m >> 8) * (256 * 1024) + (c >> 6) * (256 * 64) + (m & 255) * 64 + (c & 63)] << 16); } }
#endif
extern "C" void kernel_launch(void* const* d_in, const int* in_sizes, int n_in, void* d_out, int out_size, void* d_ws, size_t ws_size, hipStream_t stream) {
    static int grid = 0;
    if (grid == 0) {
        int dev = 0, cus = 0;
        if (n_in != 20 || out_size != TOK * DM || ws_size < WS_END) { fprintf(stderr, "kernel_launch: unexpected shapes (n_in %d out %d ws %zu)\n", n_in, out_size, ws_size); grid = -1; return; }
        if (hipGetDevice(&dev) != hipSuccess || hipDeviceGetAttribute(&cus, hipDeviceAttributeMultiprocessorCount, dev) != hipSuccess) { grid = -1; return; }
        if (hipFuncSetAttribute((const void*)mega_fwd, hipFuncAttributeMaxDynamicSharedMemorySize, LDS_BYTES) != hipSuccess) { fprintf(stderr, "kernel_launch: hipFuncSetAttribute failed\n"); grid = -1; return; }
        (void)hipGetLastError();
        grid = cus;
        if (grid != 256) fprintf(stderr, "kernel_launch: %d CUs; this kernel is built for 256\n", grid);
    }
    if (grid < 0) return;
    (void)hipMemsetAsync((char*)d_ws + WS_CTL, 0, CTL_ZERO_BYTES, stream);
    Args a{};
    for (int i = 0; i < 20; ++i) a.in[i] = (const float*)d_in[i];
    a.out = (float*)d_out; a.ws = (unsigned char*)d_ws; a.n_sub = FAST_SUBS; a.pad = 0;
    hipLaunchKernelGGL(mega_fwd, dim3(grid), dim3(NWAVES * 64), LDS_BYTES, stream, a);
#if FAST_SUBS < 8
    {
        using namespace nv;
        const float* norm_mix = (const float*)d_in[1]; const float* norm_mlp = (const float*)d_in[2];
        const float* w_qkv = (const float*)d_in[3]; const float* w_o = (const float*)d_in[4]; const float* rel = (const float*)d_in[5];
        const float* r_win = (const float*)d_in[6]; const float* r_bin = (const float*)d_in[7]; const float* r_cw = (const float*)d_in[8]; const float* r_cb = (const float*)d_in[9];
        const float* r_wga = (const float*)d_in[10]; const float* r_bga = (const float*)d_in[11]; const float* r_wgx = (const float*)d_in[12]; const float* r_bgx = (const float*)d_in[13];
        const float* r_ap = (const float*)d_in[14]; const float* r_wo = (const float*)d_in[15]; const float* r_bo = (const float*)d_in[16];
        const float* w1 = (const float*)d_in[17]; const float* w2 = (const float*)d_in[18]; const float* norm_final = (const float*)d_in[19];
        float* h = (float*)d_out; float* wsf = (float*)((char*)d_ws + 64 * MiB);
        float* hn = wsf; float* big = hn + (size_t)S * D; float* t1 = big + (size_t)S * FF; float* t2 = t1 + (size_t)S * D; float* t3 = t2 + (size_t)S * D;
        if (FAST_SUBS == 0) (void)hipMemcpyAsync(h, d_in[0], (size_t)B * S * D * 4, hipMemcpyDeviceToDevice, stream);
        else dbg_bf2f<<<4096, 256, 0, stream>>>((const unsigned short*)((char*)d_ws + WS_HB), h, (size_t)B * S * D);
        for (int sub = FAST_SUBS; sub < 8; ++sub) {
            const int layer = sub >> 1, j = layer / 2;
            for (int b = 0; b < B; ++b) {
                float* hb = h + (size_t)b * S * D;
                if ((sub & 1) == 0) {
                    rmsnorm_k<<<S, 256, 0, stream>>>(hb, norm_mix + layer * D, hn);
                    if (layer % 2 == 0) {
                        gemm_k<<<dim3(3 * D / 64, S / 64), 256, 0, stream>>>(hn, D, w_qkv + (size_t)j * D * 3 * D, 3 * D, big, 3 * D, nullptr, nullptr, 0, D, 0);
                        attn_k<<<dim3(S / CH, H), 64, 0, stream>>>(big, rel + (size_t)j * H * NREL, t1);
                        gemm_k<<<dim3(D / 64, S / 64), 256, 0, stream>>>(t1, D, w_o + (size_t)j * D * D, D, hb, D, nullptr, hb, D, D, 0);
                    } else {
                        gemm_k<<<dim3(2 * DR / 64, S / 64), 256, 0, stream>>>(hn, D, r_win + (size_t)j * D * 2 * DR, 2 * DR, big, 2 * DR, r_bin + (size_t)j * 2 * DR, nullptr, 0, D, 0);
                        conv_k<<<S, 256, 0, stream>>>(big, r_cw + (size_t)j * 4 * DR, r_cb + (size_t)j * DR, t1);
                        gates_k<<<S, 256, 0, stream>>>(t1, r_wga + (size_t)j * NB * RB * RB, r_bga + (size_t)j * DR, r_wgx + (size_t)j * NB * RB * RB, r_bgx + (size_t)j * DR, r_ap + (size_t)j * DR, t2, t3);
                        scan_k<<<DR / 64, 64, 0, stream>>>(t2, t3, big, t1);
                        gemm_k<<<dim3(D / 64, S / 64), 256, 0, stream>>>(t1, DR, r_wo + (size_t)j * DR * D, D, hb, D, r_bo + (size_t)j * D, hb, D, DR, 0);
                    }
                } else {
                    rmsnorm_k<<<S, 256, 0, stream>>>(hb, norm_mlp + layer * D, hn);
                    gemm_k<<<dim3(FF / 64, S / 64), 256, 0, stream>>>(hn, D, w1 + (size_t)layer * D * FF, FF, big, FF, nullptr, nullptr, 0, D, 1);
                    gemm_k<<<dim3(D / 64, S / 64), 256, 0, stream>>>(big, FF, w2 + (size_t)layer * FF * D, D, hb, D, nullptr, hb, D, FF, 0);
                }
            }
        }
        for (int b = 0; b < B; ++b) { float* hb = h + (size_t)b * S * D; rmsnorm_k<<<S, 256, 0, stream>>>(hb, norm_final, hb); }
    }
#endif
}
```

```cpp
#include <hip/hip_runtime.h>
#include <hip/hip_bf16.h>
#include <cstdio>
#include <cstdint>
#include <math.h>
#ifndef FAST_SUBS
#define FAST_SUBS 8
#endif
namespace pg8 {
#define PG8_LAS __attribute__((address_space(3)))
typedef unsigned short bf16_t;
typedef short bf16x8 __attribute__((ext_vector_type(8)));
typedef float f32x4 __attribute__((ext_vector_type(4)));
typedef float f32x2 __attribute__((ext_vector_type(2)));
typedef unsigned u32x4 __attribute__((ext_vector_type(4)));
typedef unsigned u32x2 __attribute__((ext_vector_type(2)));
constexpr int BM = 256, BK = 64, HALF = 128, HTB = HALF * BK * 2  , STAGE_BYTES = 8 * HTB, NXCD = 8, WGM = 8;
constexpr int TOK = 16384, DMODEL = 1024, SEQL = 2048;
constexpr size_t PANEL_BYTES = 2752512;
constexpr int PO_Z = 0, PO_Q = 0, PO_K = 512 * 1024, PO_V = 1024 * 1024, PO_O = 1536 * 1024, PO_Y = 0, PO_AL = 512 * 1024, PO_BQ = 1024 * 1024, PO_G = 1536 * 1024, PO_X = 2048 * 1024;
static_assert((size_t)PO_X + 259 * 2048 <= PANEL_BYTES, "panel map");
constexpr int KT = 256 * 64, KTX = 259 * 64;

constexpr float RMS_EPS = 1e-6f;
constexpr float C2 = 0.125f * 1.4426950408889634f;

__host__ __device__ __forceinline__ int lds_byte(int r, int c) { const int st = (r >> 4) * 2 + (c >> 5), rr = r & 15, cc = c & 31, ob = rr * 64 + cc * 2; return st * 1024 + (ob ^ (((ob >> 9) & 1) << 5)); }
__host__ __device__ __forceinline__ void stage_rc(int b, int& R, int& C) { const int st = b / 1024, sb = b % 1024, swz = sb ^ (((sb >> 9) & 1) << 5); R = (st >> 1) * 16 + swz / 64; C = (st & 1) * 32 + (swz % 64) / 2; }
__host__ __device__ __forceinline__ int perm32(int rho) { const int n = rho >> 4, i = rho & 15; return 8 * (i >> 2) + 4 * n + (i & 3); }

struct Unit { int pm, pn; };
struct Gemm { const char* A; size_t apstride; const bf16_t* Bt; int K; int lda; int kts; };
template <int MODE> __device__ __forceinline__ const char* a_base(const Gemm& g, const Unit& u) {
    if (MODE == 0) return g.A + (size_t)u.pm * g.apstride;
    return g.A + (size_t)u.pm * g.apstride + (size_t)(2 * u.pn) * (KTX * 2);
}
template <int MODE> __device__ __forceinline__ size_t koff(const Gemm& g, int t) {
    if (MODE == 0) return (size_t)t * (size_t)g.kts;
    return (size_t)(t & 1) * (KTX * 2) + (size_t)(t >> 1) * 128;
}

struct StaticOrder {
    int nM, nN, nwg, G, c;
    __host__ __device__ void init(int M, int N, int G_, int c_) { nM = M / BM; nN = N / BM; nwg = nM * nN; G = G_; c = c_; }
    __host__ __device__ bool next(int i, Unit& u) const {
        const long L = (long)i * G + c; if (L >= nwg) return false;
        int wgid = (int)L; { const int q = nwg / NXCD, r = nwg % NXCD, xcd = wgid % NXCD, off = wgid / NXCD; wgid = (xcd < r ? xcd * (q + 1) : r * (q + 1) + (xcd - r) * q) + off; }
        const int nig = WGM * nN, gid = wgid / nig, fm = gid * WGM, gsz = (nM - fm) < WGM ? (nM - fm) : WGM;
        u.pm = fm + ((wgid % nig) % gsz); u.pn = (wgid % nig) / gsz; return true;
    }
};

__device__ __forceinline__ unsigned cvt_pk_bf16(float lo, float hi) { unsigned r; asm volatile("v_cvt_pk_bf16_f32 %0, %1, %2" : "=v"(r) : "v"(lo), "v"(hi)); return r; }
__device__ __forceinline__ void st16(bf16_t* p, u32x4 v) { *(u32x4*)p = v; }
__device__ __forceinline__ float quarter_sum(float s) {
    s += __int_as_float(__builtin_amdgcn_ds_swizzle(__float_as_int(s), 0x401F));
    const auto rr = __builtin_amdgcn_permlane32_swap(__float_as_uint(s), __float_as_uint(s), false, false);
    return __uint_as_float(rr[0]) + __uint_as_float(rr[1]);
}
__device__ __forceinline__ int tid_of(int wave) { unsigned m = ~0u; asm volatile("" : "+s"(m));
    return wave * 64 + (int)__builtin_amdgcn_mbcnt_hi(m, __builtin_amdgcn_mbcnt_lo(m, 0u)); }
__device__ __forceinline__ float bf_lo(unsigned u) { return __uint_as_float(u << 16); }
__device__ __forceinline__ float bf_hi(unsigned u) { return __uint_as_float(u & 0xffff0000u); }
constexpr int RSTD_LDS_OFF = 131072 + 2048;
__device__ __forceinline__ float rstd_of(const float* ssq, int row) {
    const float s = (ssq[row] + ssq[TOK + row]) + (ssq[2 * TOK + row] + ssq[3 * TOK + row]);
    return __builtin_amdgcn_rsqf(s * (1.0f / DMODEL) + RMS_EPS);
}


struct EpiQKV {
    static constexpr bool PERM = true, AFTER_DRAIN = false, NEED_RSTD = true;
    unsigned char* big; const float* ssq;
    __device__ __forceinline__ void operator()(const f32x4 (&acc)[2][2][4][2], const Unit& u, int wr, int wc, int fr, int fq, const PG8_LAS float* rstdL) const {
        const int t = u.pn >> 2; bf16_t* base = (bf16_t*)(big + (size_t)u.pm * PANEL_BYTES + PO_Q + (size_t)t * (PO_K - PO_Q)); const float sc0 = t == 0 ? C2 : 1.f;
        const int rl0 = wr * 64 + fr; const size_t co = (size_t)(4 * (u.pn & 3) + (wc >> 1)) * KT + 32 * (wc & 1) + 8 * fq;
#pragma unroll
        for (int ai = 0; ai < 2; ++ai)
#pragma unroll
            for (int m = 0; m < 4; ++m) { const int rl = rl0 + ai * HALF + m * 16; const float sc = rstdL[rl] * sc0; bf16_t* rowp = base + co + (size_t)rl * 64;
#pragma unroll
                for (int bj = 0; bj < 2; ++bj) { const f32x4 v0 = acc[ai][bj][m][0] * sc, v1 = acc[ai][bj][m][1] * sc;
                    u32x4 w; w.x = cvt_pk_bf16(v0[0], v0[1]); w.y = cvt_pk_bf16(v0[2], v0[3]); w.z = cvt_pk_bf16(v1[0], v1[1]); w.w = cvt_pk_bf16(v1[2], v1[3]);
                    *(u32x4*)(rowp + (size_t)bj * (2 * KT)) = w; } }
    }
};
struct EpiUp {
    static constexpr bool PERM = true, AFTER_DRAIN = false, NEED_RSTD = true;
    unsigned char* big; const float* ssq;
    __device__ __forceinline__ void operator()(const f32x4 (&acc)[2][2][4][2], const Unit& u, int wr, int wc, int fr, int fq, const PG8_LAS float* rstdL) const {
        bf16_t* base = (bf16_t*)(big + (size_t)u.pm * PANEL_BYTES + PO_Z);
        const int rl0 = wr * 64 + fr; const size_t co = (size_t)(4 * u.pn + (wc >> 1)) * 16384 + 32 * (wc & 1) + 8 * fq;
#pragma unroll
        for (int ai = 0; ai < 2; ++ai)
#pragma unroll
            for (int m = 0; m < 4; ++m) { const int rl = rl0 + ai * HALF + m * 16; const float sc = rstdL[rl]; bf16_t* rowp = base + co + (size_t)rl * 64;
#pragma unroll
                for (int bj = 0; bj < 2; ++bj) { f32x4 v0 = acc[ai][bj][m][0] * sc, v1 = acc[ai][bj][m][1] * sc;
#pragma unroll
                    for (int i = 0; i < 4; ++i) { v0[i] = fmaxf(v0[i], 0.f); v1[i] = fmaxf(v1[i], 0.f); }
                    v0 = v0 * v0; v1 = v1 * v1;
                    u32x4 w; w.x = cvt_pk_bf16(v0[0], v0[1]); w.y = cvt_pk_bf16(v0[2], v0[3]); w.z = cvt_pk_bf16(v1[0], v1[1]); w.w = cvt_pk_bf16(v1[2], v1[3]);
                    st16(rowp + (size_t)bj * 32768, w); } }
    }
};
__device__ __forceinline__ float gelu_tanh(float v) {
    const float z = v * (1.0f + 0.044715f * v * v) * (-2.0f * 0.7978845608028654f * 1.4426950408889634f);
    return v * __builtin_amdgcn_rcpf(1.0f + __builtin_amdgcn_exp2f(z));
}
struct EpiIn {
    static constexpr bool PERM = true, AFTER_DRAIN = false, NEED_RSTD = true;
    unsigned char* big; const float* ssq; const float* bias;
    __device__ __forceinline__ void operator()(const f32x4 (&acc)[2][2][4][2], const Unit& u, int wr, int wc, int fr, int fq, const PG8_LAS float* rstdL) const {
        const bool isy = u.pn >= 4, has_nxt = (u.pm & 7) != 7;
        unsigned char* pan = big + (size_t)u.pm * PANEL_BYTES;
        asm volatile("" : "+v"(fr));
        const int rl0 = wr * 64 + fr, ktl = 4 * (u.pn & 3) + (wc >> 1), cl = 32 * (wc & 1) + 8 * fq, bcol0 = u.pn * BM + wc * 32 + 8 * fq;
        f32x4 bv[2][2];
#pragma unroll
        for (int bj = 0; bj < 2; ++bj)
#pragma unroll
            for (int n = 0; n < 2; ++n) bv[bj][n] = *(const f32x4*)(bias + bcol0 + bj * HALF + 4 * n);
#pragma unroll
        for (int ai = 0; ai < 2; ++ai)
#pragma unroll
            for (int m = 0; m < 4; ++m) { const int rl = rl0 + ai * HALF + m * 16; const float sc = rstdL[rl];
                const size_t kst = isy ? (size_t)KT : (size_t)KTX;
                bf16_t* rowp = isy ? ((bf16_t*)(pan + PO_Y) + (size_t)ktl * KT + (size_t)rl * 64 + cl) : ((bf16_t*)(pan + PO_X) + (size_t)ktl * KTX + (size_t)(rl + 3) * 64 + cl);
                const bool halo = !isy && has_nxt && rl >= BM - 3;
                bf16_t* hrow = (bf16_t*)(pan + PANEL_BYTES + PO_X) + (size_t)ktl * KTX + (size_t)(rl - (BM - 3)) * 64 + cl;
#pragma unroll
                for (int bj = 0; bj < 2; ++bj) { f32x4 v0 = acc[ai][bj][m][0] * sc + bv[bj][0], v1 = acc[ai][bj][m][1] * sc + bv[bj][1];
                    if (isy) {
#pragma unroll
                        for (int i = 0; i < 4; ++i) { v0[i] = gelu_tanh(v0[i]); v1[i] = gelu_tanh(v1[i]); } }
                    u32x4 w; w.x = cvt_pk_bf16(v0[0], v0[1]); w.y = cvt_pk_bf16(v0[2], v0[3]); w.z = cvt_pk_bf16(v1[0], v1[1]); w.w = cvt_pk_bf16(v1[2], v1[3]);
                    *(u32x4*)(rowp + (size_t)bj * 2 * kst) = w;
                    if (halo) *(u32x4*)(hrow + (size_t)bj * 2 * KTX) = w; } }
    }
};
struct EpiGate {
    static constexpr bool PERM = true, AFTER_DRAIN = false, NEED_RSTD = false;
    unsigned char* big; const float* gc;
    __device__ __forceinline__ void operator()(const f32x4 (&acc)[2][2][4][2], const Unit& u, int wr, int wc, int fr, int fq, const PG8_LAS float*) const {
        const int rl0 = wr * 64 + fr, ch0 = u.pn * 128 + wc * 32 + 8 * fq;
        bf16_t* AL = (bf16_t*)(big + (size_t)u.pm * PANEL_BYTES + PO_AL); bf16_t* BQ = (bf16_t*)(big + (size_t)u.pm * PANEL_BYTES + PO_BQ);
        float ba[8], bx[8], c8[8];
#pragma unroll
        for (int i = 0; i < 8; ++i) { const f32x4 c = *(const f32x4*)(gc + (size_t)(ch0 + i) * 8); ba[i] = c[0]; bx[i] = c[1]; c8[i] = c[3]; }
#pragma unroll
        for (int ai = 0; ai < 2; ++ai)
#pragma unroll
            for (int m = 0; m < 4; ++m) { const int row = rl0 + ai * HALF + m * 16;
                float la2[8], bq[8];
#pragma unroll
                for (int i = 0; i < 8; ++i) { const float ga = acc[ai][0][m][i >> 2][i & 3], gx = acc[ai][1][m][i >> 2][i & 3];
                    const float r = __builtin_amdgcn_rcpf(1.0f + __builtin_amdgcn_exp2f(-(ga + ba[i]) * 1.4426950408889634f));
                    const float ig = __builtin_amdgcn_rcpf(1.0f + __builtin_amdgcn_exp2f(-(gx + bx[i]) * 1.4426950408889634f));
                    la2[i] = c8[i] * r;
                    const float om = 1.0f - __builtin_amdgcn_exp2f(2.0f * la2[i]);
                    bq[i] = __builtin_amdgcn_sqrtf(om) * ig; }
                u32x4 wa, wb;
                wa.x = cvt_pk_bf16(la2[0], la2[1]); wa.y = cvt_pk_bf16(la2[2], la2[3]); wa.z = cvt_pk_bf16(la2[4], la2[5]); wa.w = cvt_pk_bf16(la2[6], la2[7]);
                wb.x = cvt_pk_bf16(bq[0], bq[1]); wb.y = cvt_pk_bf16(bq[2], bq[3]); wb.z = cvt_pk_bf16(bq[4], bq[5]); wb.w = cvt_pk_bf16(bq[6], bq[7]);
                const size_t eo = (size_t)(2 * u.pn + (wc >> 1)) * KT + (size_t)row * 64 + 32 * (wc & 1) + 8 * fq;
                *(u32x4*)(AL + eo) = wa; *(u32x4*)(BQ + eo) = wb;
            }
    }
};
struct EpiRes {
    static constexpr bool PERM = true, AFTER_DRAIN = true, NEED_RSTD = false;
    bf16_t* hb; float* ssq; const float* bias;
    __device__ __forceinline__ void prefetch(u32x4 (&pre)[4][2], const Unit& u, int wr, int wc, int fr, int fq) const {
        const bf16_t* hbp = hb + (size_t)u.pm * (BM * DMODEL) + (size_t)(4 * u.pn + (wc >> 1)) * KT + 32 * (wc & 1) + 8 * fq;
#pragma unroll
        for (int m = 0; m < 4; ++m)
#pragma unroll
            for (int bj = 0; bj < 2; ++bj) pre[m][bj] = *(const u32x4*)(hbp + (size_t)(wr * 64 + m * 16 + fr) * 64 + (size_t)bj * (2 * KT));
    }
    __device__ __forceinline__ void fused(f32x4 (&acc)[2][2][4][2], const u32x4 (&pre)[4][2], const Unit& u, int wr, int wc, int fr, int fq, PG8_LAS unsigned char* lds, int wid, int lane) const {
        PG8_LAS float* P = (PG8_LAS float*)lds;
        const int col0 = u.pn * BM + wc * 32 + 8 * fq;
        bf16_t* hbp = hb + (size_t)u.pm * (BM * DMODEL) + (size_t)(4 * u.pn + (wc >> 1)) * KT + 32 * (wc & 1) + 8 * fq;
        f32x4 bv[2][2];
#pragma unroll
        for (int bj = 0; bj < 2; ++bj)
#pragma unroll
            for (int n = 0; n < 2; ++n) bv[bj][n] = bias ? *(const f32x4*)(bias + col0 + bj * HALF + 4 * n) : (f32x4){0.f, 0.f, 0.f, 0.f};
#pragma unroll
        for (int ai = 0; ai < 2; ++ai) {
            u32x4 rr[4][2];
#pragma unroll
            for (int m = 0; m < 4; ++m)
#pragma unroll
                for (int bj = 0; bj < 2; ++bj) rr[m][bj] = (ai == 0) ? pre[m][bj] : *(const u32x4*)(hbp + (size_t)(ai * HALF + wr * 64 + m * 16 + fr) * 64 + (size_t)bj * (2 * KT));
#pragma unroll
            for (int m = 0; m < 4; ++m) { const int rl = ai * HALF + wr * 64 + m * 16 + fr;
                float s = 0.f;
#pragma unroll
                for (int bj = 0; bj < 2; ++bj) { const u32x4 r = rr[m][bj];
                    const f32x4 r0 = (f32x4){bf_lo(r.x), bf_hi(r.x), bf_lo(r.y), bf_hi(r.y)}, r1 = (f32x4){bf_lo(r.z), bf_hi(r.z), bf_lo(r.w), bf_hi(r.w)};
                    const f32x4 v0 = acc[ai][bj][m][0] + bv[bj][0] + r0, v1 = acc[ai][bj][m][1] + bv[bj][1] + r1;
                    s += (v0[0] * v0[0] + v0[1] * v0[1]) + (v0[2] * v0[2] + v0[3] * v0[3]) + (v1[0] * v1[0] + v1[1] * v1[1]) + (v1[2] * v1[2] + v1[3] * v1[3]);
                    u32x4 w; w.x = cvt_pk_bf16(v0[0], v0[1]); w.y = cvt_pk_bf16(v0[2], v0[3]); w.z = cvt_pk_bf16(v1[0], v1[1]); w.w = cvt_pk_bf16(v1[2], v1[3]);
                    *(u32x4*)(hbp + (size_t)rl * 64 + (size_t)bj * (2 * KT)) = w;
                }
                s = quarter_sum(s);
                if (fq == 0) P[wc * 256 + rl] = s;
            }
            asm volatile("" ::: "memory");
        }
        asm volatile("s_waitcnt lgkmcnt(0)" ::: "memory"); __builtin_amdgcn_s_barrier(); asm volatile("" ::: "memory");
        const int tid = wid * 64 + lane;
        if (tid < 256) { const float s = (P[tid] + P[256 + tid]) + (P[512 + tid] + P[768 + tid]); ssq[(size_t)u.pn * TOK + u.pm * BM + tid] = s; }
    }
};

template <class Epi, int MODE, bool ALIGN_EPI = false, bool SP2 = false>
__device__ __forceinline__ void gemm_phase(PG8_LAS unsigned char* lds, const Gemm g, const StaticOrder& S, const Epi& E, int wave) {
    int tid_ = tid_of(wave); asm volatile("" : "+v"(tid_));
    const int tid = tid_, wid = __builtin_amdgcn_readfirstlane(tid >> 6), lane = tid & 63, wr = wid >> 2, wc = wid & 3, fr = lane & 15, fq = lane >> 4;
    const int K = g.K, nt = K / BK, lda = g.lda;
    unsigned voffA[2], voffB[2];
#pragma unroll
    for (int i = 0; i < 2; ++i) { int R, C; stage_rc(tid * 16 + i * 8192, R, C); const int Rb = Epi::PERM ? ((R & ~31) + perm32(R & 31)) : R;
        voffA[i] = (unsigned)(R * lda + C) * 2u; voffB[i] = (unsigned)(Rb * K + C) * 2u; }
    const size_t kstep = (size_t)(BK * 2);
    const size_t hstepA = (size_t)HALF * lda * 2, hstepB = (size_t)HALF * K * 2;
    const unsigned ldsw = (unsigned)wid * 1024u;
    const int aoff = lds_byte(wr * 64 + fr, fq * 8), boff = lds_byte(wc * 32 + fr, fq * 8);
#define PG8_SA(b, h) (((b) * 2 + (h)) * HTB)
#define PG8_SB(b, h) ((4 + (b) * 2 + (h)) * HTB)
#define PG8_STAGE(bufoff, gbase, voff) do { _Pragma("unroll") for (int _i = 0; _i < 2; ++_i) \
        __builtin_amdgcn_global_load_lds((const unsigned*)((const char*)(gbase) + (voff)[_i]), (PG8_LAS unsigned*)(lds + (bufoff) + ldsw + _i * 8192), 16, 0, 0); } while (0)
#define PG8_LDA(dst, b, h) do { _Pragma("unroll") for (int m = 0; m < 4; ++m) _Pragma("unroll") for (int k = 0; k < 2; ++k) dst[m][k] = *(const PG8_LAS bf16x8*)(lds + PG8_SA(b, h) + aoff + m * 2048 + k * 1024); } while (0)
#define PG8_LDB(dst, b, h) do { _Pragma("unroll") for (int n = 0; n < 2; ++n) _Pragma("unroll") for (int k = 0; k < 2; ++k) dst[n][k] = *(const PG8_LAS bf16x8*)(lds + PG8_SB(b, h) + boff + n * 2048 + k * 1024); } while (0)
#define PG8_MMA(ai, bj, At, Bt) do { __builtin_amdgcn_s_setprio(1); _Pragma("unroll") for (int m = 0; m < 4; ++m) _Pragma("unroll") for (int n = 0; n < 2; ++n) _Pragma("unroll") for (int k = 0; k < 2; ++k) \
        acc[ai][bj][m][n] = __builtin_amdgcn_mfma_f32_16x16x32_bf16(Bt[n][k], At[m][k], acc[ai][bj][m][n], 0, 0, 0); __builtin_amdgcn_s_setprio(0); } while (0)
#define PG8_WAIT_V(n) asm volatile("s_waitcnt vmcnt(" #n ")" ::: "memory")
#define PG8_WAIT_L(n) asm volatile("s_waitcnt lgkmcnt(" #n ")" ::: "memory")
#define PG8_BAR __builtin_amdgcn_s_barrier()
#define PG8_SCHED __builtin_amdgcn_sched_barrier(0)
    Unit cur, nxt; int ui = 0;
    if (!S.next(0, cur)) return;
    f32x4 acc[2][2][4][2];
#pragma unroll
    for (int a = 0; a < 2; ++a)
#pragma unroll
        for (int b = 0; b < 2; ++b)
#pragma unroll
            for (int m = 0; m < 4; ++m)
#pragma unroll
                for (int n = 0; n < 2; ++n) acc[a][b][m][n] = (f32x4){0.f, 0.f, 0.f, 0.f};
    bf16x8 At[4][2], B0[2][2], B1[2][2];
    const char* cA = a_base<MODE>(g, cur); const char* cB = (const char*)g.Bt + (size_t)cur.pn * 2 * hstepB;
    const size_t ko1 = koff<MODE>(g, 1);
    const PG8_LAS float* rstdL = (const PG8_LAS float*)(lds + RSTD_LDS_OFF);
    float my_rstd = 0.f;
    if constexpr (Epi::NEED_RSTD) { if (tid < BM) my_rstd = rstd_of(E.ssq, cur.pm * BM + tid); }
    if constexpr (SP2) {
        PG8_STAGE(PG8_SB(0, 0), cB, voffB); PG8_STAGE(PG8_SB(0, 1), cB + hstepB, voffB); PG8_STAGE(PG8_SA(0, 0), cA, voffA); PG8_STAGE(PG8_SA(0, 1), cA + hstepA, voffA);
        if (wr == 1) PG8_BAR;
        PG8_WAIT_V(2); PG8_BAR;
        PG8_STAGE(PG8_SB(1, 0), cB + kstep, voffB); PG8_STAGE(PG8_SA(1, 0), cA + ko1, voffA); PG8_STAGE(PG8_SB(1, 1), cB + hstepB + kstep, voffB);
        PG8_WAIT_V(6); PG8_BAR;
    } else {
        PG8_STAGE(PG8_SB(0, 0), cB, voffB); PG8_STAGE(PG8_SA(0, 0), cA, voffA); PG8_STAGE(PG8_SB(0, 1), cB + hstepB, voffB); PG8_STAGE(PG8_SA(0, 1), cA + hstepA, voffA);
        if (wr == 1) PG8_BAR;
        PG8_WAIT_V(4); PG8_BAR;
        PG8_STAGE(PG8_SB(1, 0), cB + kstep, voffB); PG8_STAGE(PG8_SA(1, 0), cA + ko1, voffA); PG8_STAGE(PG8_SB(1, 1), cB + hstepB + kstep, voffB);
        PG8_WAIT_V(6); PG8_BAR;
    }
    if constexpr (Epi::NEED_RSTD) { if (tid < BM) ((PG8_LAS float*)(lds + RSTD_LDS_OFF))[tid] = my_rstd; }
    for (;;) {
        const bool has_next = S.next(ui + 1, nxt);
        const char* nA = has_next ? a_base<MODE>(g, nxt) : cA; const char* nB = has_next ? (const char*)g.Bt + (size_t)nxt.pn * 2 * hstepB : cB;
        for (int t = 0; t < nt; t += 2) {
            const bool last = (t == nt - 2);
            const char* a1 = cA + koff<MODE>(g, t + 1);
            const char* a2 = last ? nA : cA + koff<MODE>(g, t + 2); const char* b2 = last ? nB : cB + (size_t)(t + 2) * kstep;
            const char* a3 = last ? nA + ko1 : cA + koff<MODE>(g, t + 3); const char* b3 = b2 + kstep;
            if constexpr (SP2) {
            PG8_LDB(B0, 0, 0); PG8_LDB(B1, 0, 1); PG8_SCHED; PG8_LDA(At, 0, 0); PG8_STAGE(PG8_SA(1, 1), a1 + hstepA, voffA);
            PG8_WAIT_V(8); PG8_WAIT_L(0); PG8_BAR; PG8_MMA(0, 0, At, B0); PG8_MMA(0, 1, At, B1); PG8_BAR; PG8_SCHED;
            PG8_LDA(At, 0, 1); PG8_STAGE(PG8_SB(0, 0), b2, voffB); PG8_STAGE(PG8_SB(0, 1), b2 + hstepB, voffB); PG8_STAGE(PG8_SA(0, 0), a2, voffA);
            PG8_WAIT_V(8); PG8_WAIT_L(0); PG8_BAR; PG8_MMA(1, 0, At, B0); PG8_MMA(1, 1, At, B1); PG8_BAR; PG8_SCHED;
            PG8_LDB(B0, 1, 0); PG8_LDB(B1, 1, 1); PG8_SCHED; PG8_LDA(At, 1, 0); PG8_STAGE(PG8_SA(0, 1), a2 + hstepA, voffA);
            PG8_WAIT_V(8); PG8_WAIT_L(0); PG8_BAR; PG8_MMA(0, 0, At, B0); PG8_MMA(0, 1, At, B1); PG8_BAR; PG8_SCHED;
            PG8_LDA(At, 1, 1); PG8_STAGE(PG8_SB(1, 0), b3, voffB); PG8_STAGE(PG8_SB(1, 1), b3 + hstepB, voffB); PG8_STAGE(PG8_SA(1, 0), a3, voffA);
            PG8_WAIT_V(8); PG8_WAIT_L(0); PG8_BAR; PG8_MMA(1, 0, At, B0); PG8_MMA(1, 1, At, B1); PG8_BAR; PG8_SCHED;
            } else {
            PG8_LDB(B0, 0, 0); PG8_SCHED; PG8_LDA(At, 0, 0); PG8_STAGE(PG8_SA(1, 1), a1 + hstepA, voffA);
            PG8_WAIT_L(8); PG8_BAR; PG8_WAIT_L(0); PG8_MMA(0, 0, At, B0); PG8_BAR; PG8_SCHED;
            PG8_LDB(B1, 0, 1); PG8_STAGE(PG8_SB(0, 0), b2, voffB);
            PG8_BAR; PG8_WAIT_L(0); PG8_MMA(0, 1, At, B1); PG8_BAR;
            PG8_LDA(At, 0, 1); PG8_STAGE(PG8_SA(0, 0), a2, voffA);
            PG8_BAR; PG8_WAIT_L(0); PG8_MMA(1, 0, At, B0); PG8_BAR; PG8_SCHED;
            PG8_STAGE(PG8_SB(0, 1), b2 + hstepB, voffB);
            PG8_WAIT_V(6); PG8_BAR; PG8_MMA(1, 1, At, B1); PG8_BAR;
            PG8_LDB(B0, 1, 0); PG8_SCHED; PG8_LDA(At, 1, 0); PG8_STAGE(PG8_SA(0, 1), a2 + hstepA, voffA);
            PG8_WAIT_L(8); PG8_BAR; PG8_WAIT_L(0); PG8_MMA(0, 0, At, B0); PG8_BAR; PG8_SCHED;
            PG8_LDB(B1, 1, 1); PG8_STAGE(PG8_SB(1, 0), b3, voffB);
            PG8_BAR; PG8_WAIT_L(0); PG8_MMA(0, 1, At, B1); PG8_BAR;
            PG8_LDA(At, 1, 1); PG8_STAGE(PG8_SA(1, 0), a3, voffA);
            PG8_BAR; PG8_WAIT_L(0); PG8_MMA(1, 0, At, B0); PG8_BAR; PG8_SCHED;
            PG8_STAGE(PG8_SB(1, 1), b3 + hstepB, voffB);
            PG8_WAIT_V(6); PG8_BAR; PG8_MMA(1, 1, At, B1); PG8_BAR;
            }
        }
        if constexpr (ALIGN_EPI) { if (wr == 0) PG8_BAR; }
        if constexpr (!Epi::AFTER_DRAIN) { E(acc, cur, wr, wc, fr, fq, rstdL); }
        if (!has_next) break;
#pragma unroll
        for (int a = 0; a < 2; ++a)
#pragma unroll
            for (int b = 0; b < 2; ++b)
#pragma unroll
                for (int m = 0; m < 4; ++m)
#pragma unroll
                    for (int n = 0; n < 2; ++n) acc[a][b][m][n] = (f32x4){0.f, 0.f, 0.f, 0.f};
        cur = nxt; cA = nA; cB = nB; ++ui;
        if constexpr (ALIGN_EPI) { if (wr == 1) PG8_BAR; }
    }
    u32x4 pre[4][2];
    if constexpr (Epi::AFTER_DRAIN) E.prefetch(pre, cur, wr, wc, fr, fq);
    PG8_WAIT_V(0);
    if constexpr (!ALIGN_EPI) { if (wr == 0) PG8_BAR; }
    PG8_BAR;
    if constexpr (Epi::AFTER_DRAIN) { E.fused(acc, pre, cur, wr, wc, fr, fq, lds, wid, lane); }
#undef PG8_SA
#undef PG8_SB
#undef PG8_STAGE
#undef PG8_LDA
#undef PG8_LDB
#undef PG8_MMA
#undef PG8_WAIT_V
#undef PG8_WAIT_L
#undef PG8_BAR
#undef PG8_SCHED
}
}
namespace att {
using bf16x8 = __attribute__((ext_vector_type(8))) short;
using s16x4 = __attribute__((ext_vector_type(4))) short;
using f32x16 = __attribute__((ext_vector_type(16))) float;
using f32x4 = __attribute__((ext_vector_type(4))) float;
using u32x4 = __attribute__((ext_vector_type(4))) unsigned;
typedef unsigned short bf16_t;
#define ATT_LAS __attribute__((address_space(3)))
constexpr int DM = 1024, SEQ = 2048, D = 64, NW = 8, QBLK = 32, QB = 256, KVBLK = 64;
constexpr int NSLOT = 3, SLOTB = 8192;
constexpr int L_K = 0, L_V = NSLOT * SLOTB, L_WS = 2 * NSLOT * SLOTB, L_OST = L_WS + NW * 256, L_QN = L_OST + NW * 4096, L_END = L_QN + NW * 4096;
constexpr int L_TAB = 134144, TABSZ = 1312;
constexpr int TABN = 320;
constexpr int TABR = 324;
constexpr float THR = 8.0f;
__device__ __forceinline__ int crow(int r, int hi) { return (r & 3) + 8 * (r >> 2) + 4 * hi; }
#define ASBAR() __builtin_amdgcn_sched_barrier(0)
__device__ __forceinline__ void glds16(const void* gsrc, unsigned lds_dst) { unsigned keep;
    asm volatile("s_mov_b32 %0, m0\n\ts_mov_b32 m0, %2\n\ts_nop 0\n\tglobal_load_lds_dwordx4 %1, off\n\ts_mov_b32 m0, %0" : "=&s"(keep) : "v"(gsrc), "s"(lds_dst) : "memory"); }
__device__ __forceinline__ unsigned cvtpk(float lo, float hi) { unsigned r; asm volatile("v_cvt_pk_bf16_f32 %0, %1, %2" : "=v"(r) : "v"(lo), "v"(hi)); return r; }
#define ATT_WAIT_BAR(N) asm volatile("s_waitcnt vmcnt(" #N ") lgkmcnt(0)\n\ts_barrier" ::: "memory")

__device__ __forceinline__ void vread16(s16x4* lo, s16x4* hi, int vb) {
#pragma unroll
    for (int d0 = 0; d0 < 2; ++d0)
#pragma unroll
        for (int ks = 0; ks < 4; ++ks) {
            asm volatile("ds_read_b64_tr_b16 %0,%1 offset:%c2" : "=&v"(lo[4 * d0 + ks]) : "v"(vb), "i"(d0 * 4096 + ks * 1024) : "memory");
            asm volatile("ds_read_b64_tr_b16 %0,%1 offset:%c2" : "=&v"(hi[4 * d0 + ks]) : "v"(vb), "i"(d0 * 4096 + ks * 1024 + 512) : "memory"); }
}
__device__ __forceinline__ void pv16(f32x16* o, const s16x4* lo, const s16x4* hi, bf16x8 pa0, bf16x8 pa1, bf16x8 pa2, bf16x8 pa3) {
#define ATT_PK(k) (bf16x8){lo[k][0], lo[k][1], lo[k][2], lo[k][3], hi[k][0], hi[k][1], hi[k][2], hi[k][3]}
    o[0] = __builtin_amdgcn_mfma_f32_32x32x16_bf16(pa0, ATT_PK(0), o[0], 0, 0, 0); o[1] = __builtin_amdgcn_mfma_f32_32x32x16_bf16(pa0, ATT_PK(4), o[1], 0, 0, 0);
    o[0] = __builtin_amdgcn_mfma_f32_32x32x16_bf16(pa1, ATT_PK(1), o[0], 0, 0, 0); o[1] = __builtin_amdgcn_mfma_f32_32x32x16_bf16(pa1, ATT_PK(5), o[1], 0, 0, 0);
    o[0] = __builtin_amdgcn_mfma_f32_32x32x16_bf16(pa2, ATT_PK(2), o[0], 0, 0, 0); o[1] = __builtin_amdgcn_mfma_f32_32x32x16_bf16(pa2, ATT_PK(6), o[1], 0, 0, 0);
    o[0] = __builtin_amdgcn_mfma_f32_32x32x16_bf16(pa3, ATT_PK(3), o[0], 0, 0, 0); o[1] = __builtin_amdgcn_mfma_f32_32x32x16_bf16(pa3, ATT_PK(7), o[1], 0, 0, 0);
#undef ATT_PK
}
__device__ __forceinline__ float rowmax32(const f32x16& p0, const f32x16& p1) {
    float a = fmaxf(p0[0], p1[0]);
#pragma unroll
    for (int r = 1; r < 16; ++r) a = fmaxf(a, fmaxf(p0[r], p1[r]));
    auto rr = __builtin_amdgcn_permlane32_swap(__float_as_uint(a), __float_as_uint(a), false, false);
    return fmaxf(__uint_as_float(rr[0]), __uint_as_float(rr[1]));
}

__device__ __forceinline__ void attn_tables(const float* tab, ATT_LAS unsigned char* shm, int wave) {
    const int tid = pg8::tid_of(wave); ATT_LAS float* tabL = (ATT_LAS float*)(shm + L_TAB);
    for (int idx = tid; idx < 4 * 4 * TABR; idx += NW * 64) { const int u_ = idx / (4 * TABR), r_ = idx % (4 * TABR), s_ = r_ / TABR, k_ = r_ % TABR - s_;
        tabL[u_ * TABSZ + r_] = (k_ >= 0 && k_ < TABN) ? tab[u_ * TABN + TABN - 1 - k_] : 0.f; }
}
__device__ __forceinline__ void attn_stream(int b, int qb, int h0, unsigned char* big, ATT_LAS unsigned char* shm, int wave) {
    int tid_ = pg8::tid_of(wave); asm volatile("" : "+v"(tid_));
    const int tid = tid_, lane = tid & 63, r32 = lane & 31, hi = lane >> 5; const int wid = __builtin_amdgcn_readfirstlane(tid >> 6);
    const int ci = wid >> 1;
    ATT_LAS float* wsf = (ATT_LAS float*)(shm + L_WS) + wid * 64;
    const long koffl = (long)h0 * pg8::KT + (long)lane * D + wid * 8, voffl = (long)h0 * pg8::KT + (long)(16 * (wid & 3) + (lane >> 2)) * D + (wid >> 2) * 32 + (lane & 3) * 8;
    const unsigned lds0 = (unsigned)(uintptr_t)shm;
    const unsigned kdst = lds0 + L_K + wid * 1024, vdst = lds0 + L_V + wid * 1024;
#define ATT_DMA_C(c_, u_, slotoff) do { const unsigned char* pan_ = big + (size_t)(b * 8 + ((c_) >> 2)) * pg8::PANEL_BYTES; const long ro_ = (long)(((c_) & 3) * KVBLK) * D + (long)(u_) * pg8::KT; \
        glds16((const bf16_t*)(pan_ + pg8::PO_K) + ro_ + koffl, (unsigned)__builtin_amdgcn_readfirstlane(kdst + (slotoff))); \
        glds16((const bf16_t*)(pan_ + pg8::PO_V) + ro_ + voffl, (unsigned)__builtin_amdgcn_readfirstlane(vdst + (slotoff))); } while (0)
#define ATT_LOADQ(u_) do { const bf16_t* qp_ = (const bf16_t*)(big + (size_t)(b * 8 + qb) * pg8::PANEL_BYTES + pg8::PO_Q) + (long)(h0 + (u_)) * pg8::KT + (long)(wid * QBLK) * D + lane * 8; \
        _Pragma("unroll") for (int i_ = 0; i_ < 4; ++i_) glds16(qp_ + i_ * 512, (unsigned)__builtin_amdgcn_readfirstlane(lds0 + L_QN + wid * 4096 + i_ * 1024)); } while (0)
    const int vb0 = (int)(lds0 + L_V) + ((lane >> 4) & 1) * 32 + (lane & 3) * 8 + (4 * hi + ((lane & 15) >> 2)) * 64;
    const int qi = (wid & 1) * 32 + r32;
    const int sj = (qi + 1) & 3, jb = 191 - qi + 4 * hi + sj;
    const int cs = (4 * qb - 8) > 0 ? (4 * qb - 8) : 0, NT = 4 * qb + 4 - cs, cq = 4 * qb + ci, t_lo = ((cq - 8) > 0 ? (cq - 8) : 0) - cs, t_hi = cq - cs;
    const int Gtot = 4 * NT;
    bf16x8 qr[4];
#pragma unroll
    for (int d0 = 0; d0 < 4; ++d0) qr[d0] = bf16x8{};
    ATT_LOADQ(0);
    int du = 0, dt = 0;
#define ATT_DMA_NEXT(slotoff) do { ATT_DMA_C(cs + dt, du, slotoff); if (++dt == NT) { ++du; dt = 0; } } while (0)
    ATT_DMA_NEXT(0); ATT_DMA_NEXT(SLOTB);
    int u = 0, t = 0;
    float mhat = 0.f, l_reg = 0.f, cfar = 0.f; f32x16 o[2]; o[0] = f32x16{}; o[1] = f32x16{};
    bool need_q = false, qwait = false;
    int slot = 0;
    for (int g = 0; g < Gtot; ++g) {
        if (g + 1 < Gtot) { if (qwait) { ATT_WAIT_BAR(6); } else { ATT_WAIT_BAR(2); } } else { ATT_WAIT_BAR(0); }
        qwait = false;
        if (g + 2 < Gtot) { const int s2 = (slot >= SLOTB) ? slot - SLOTB : slot + 2 * SLOTB; ATT_DMA_NEXT(s2); }
        if (need_q) { need_q = false; qwait = true; ATT_LOADQ(u + 1); }
        if (t >= t_lo && t <= t_hi) {
            const int dc = t_hi - t;
            const ATT_LAS float* tabL = (const ATT_LAS float*)(shm + L_TAB) + u * TABSZ;
            s16x4 vlo[8], vhi[8];
            vread16(vlo, vhi, vb0 + slot);
            bf16x8 kf[8];
            { const ATT_LAS unsigned char* kb = shm + L_K + slot + hi * 1024 + r32 * 16;
#pragma unroll
              for (int d0 = 0; d0 < 4; ++d0) { kf[2 * d0] = *reinterpret_cast<const ATT_LAS bf16x8*>(kb + d0 * 2048); kf[2 * d0 + 1] = *reinterpret_cast<const ATT_LAS bf16x8*>(kb + d0 * 2048 + 512); } }
            if (t == t_lo) { mhat = 0.f; l_reg = 0.f; o[0] = f32x16{}; o[1] = f32x16{};
                const ATT_LAS unsigned char* qn = shm + L_QN + wid * 4096 + r32 * 128 + hi * 16;
#pragma unroll
                for (int d0 = 0; d0 < 4; ++d0) qr[d0] = *reinterpret_cast<const ATT_LAS bf16x8*>(qn + d0 * 32);
                cfar = tabL[0];
                need_q = (u + 1 < 4); }
            f32x16 p0, p1;
            if (dc >= 3) {
                asm volatile("s_waitcnt lgkmcnt(0)" ::: "memory"); ASBAR();
#pragma unroll
                for (int r = 0; r < 16; ++r) { p0[r] = cfar - mhat; p1[r] = cfar - mhat; }
#pragma unroll
                for (int d0 = 0; d0 < 4; ++d0) { p0 = __builtin_amdgcn_mfma_f32_32x32x16_bf16(kf[2 * d0], qr[d0], p0, 0, 0, 0); p1 = __builtin_amdgcn_mfma_f32_32x32x16_bf16(kf[2 * d0 + 1], qr[d0], p1, 0, 0, 0); }
            } else {
                const ATT_LAS float* tb = tabL + sj * TABR + (jb - 64 * dc);
                f32x4 b0[4], b1[4];
#pragma unroll
                for (int g4 = 0; g4 < 4; ++g4) { b0[g4] = *(const ATT_LAS f32x4*)(tb + 8 * g4); b1[g4] = *(const ATT_LAS f32x4*)(tb + 32 + 8 * g4); }
                asm volatile("s_waitcnt lgkmcnt(0)" ::: "memory"); ASBAR();
#pragma unroll
                for (int r = 0; r < 16; ++r) { p0[r] = b0[r >> 2][r & 3] - mhat; p1[r] = b1[r >> 2][r & 3] - mhat; }
#pragma unroll
                for (int d0 = 0; d0 < 4; ++d0) { p0 = __builtin_amdgcn_mfma_f32_32x32x16_bf16(kf[2 * d0], qr[d0], p0, 0, 0, 0); p1 = __builtin_amdgcn_mfma_f32_32x32x16_bf16(kf[2 * d0 + 1], qr[d0], p1, 0, 0, 0); }
            }
            const float rm = rowmax32(p0, p1);
            if (t == t_lo) {
                mhat = rm;
#pragma unroll
                for (int r = 0; r < 16; ++r) { p0[r] -= rm; p1[r] -= rm; }
            } else if (__any(rm > THR)) {
                const float dl = fmaxf(rm, 0.f); mhat += dl;
#pragma unroll
                for (int r = 0; r < 16; ++r) { p0[r] -= dl; p1[r] -= dl; }
                const float f = __builtin_amdgcn_exp2f(-dl); l_reg *= f;
                if (hi == 0) wsf[r32] = f;
                asm volatile("s_waitcnt lgkmcnt(0)" ::: "memory");
#pragma unroll
                for (int g4 = 0; g4 < 4; ++g4) { const f32x4 fv = *(const ATT_LAS f32x4*)(wsf + 8 * g4 + 4 * hi);
#pragma unroll
                    for (int i = 0; i < 4; ++i) { o[0][4 * g4 + i] *= fv[i]; o[1][4 * g4 + i] *= fv[i]; } }
            }
            float sacc = 0.f;
#pragma unroll
            for (int r = 0; r < 16; ++r) { p0[r] = __builtin_amdgcn_exp2f(p0[r]); p1[r] = __builtin_amdgcn_exp2f(p1[r]); sacc += p0[r] + p1[r]; }
            l_reg += sacc;
            u32x4 pw0, pw1, pw2, pw3;
            pw0 = (u32x4){cvtpk(p0[0], p0[1]), cvtpk(p0[2], p0[3]), cvtpk(p0[4], p0[5]), cvtpk(p0[6], p0[7])};
            pw1 = (u32x4){cvtpk(p0[8], p0[9]), cvtpk(p0[10], p0[11]), cvtpk(p0[12], p0[13]), cvtpk(p0[14], p0[15])};
            pw2 = (u32x4){cvtpk(p1[0], p1[1]), cvtpk(p1[2], p1[3]), cvtpk(p1[4], p1[5]), cvtpk(p1[6], p1[7])};
            pw3 = (u32x4){cvtpk(p1[8], p1[9]), cvtpk(p1[10], p1[11]), cvtpk(p1[12], p1[13]), cvtpk(p1[14], p1[15])};
            ASBAR();
            pv16(o, vlo, vhi, __builtin_bit_cast(bf16x8, pw0), __builtin_bit_cast(bf16x8, pw1), __builtin_bit_cast(bf16x8, pw2), __builtin_bit_cast(bf16x8, pw3));
            if (t == t_hi) {
                { auto rr = __builtin_amdgcn_permlane32_swap(__float_as_uint(l_reg), __float_as_uint(l_reg), false, false); l_reg = __uint_as_float(rr[0]) + __uint_as_float(rr[1]); }
                if (hi == 0) wsf[32 + r32] = l_reg;
                asm volatile("s_waitcnt lgkmcnt(0)" ::: "memory");
                float rli[16];
#pragma unroll
                for (int g4 = 0; g4 < 4; ++g4) { const f32x4 lv = *(const ATT_LAS f32x4*)(wsf + 32 + 8 * g4 + 4 * hi);
#pragma unroll
                    for (int i = 0; i < 4; ++i) rli[4 * g4 + i] = __builtin_amdgcn_rcpf(lv[i]); }
                bf16_t* Ow = (bf16_t*)(big + (size_t)(b * 8 + qb) * pg8::PANEL_BYTES + pg8::PO_O) + (long)(h0 + u) * pg8::KT + (long)(wid * QBLK) * D;
                ATT_LAS bf16_t* stg = (ATT_LAS bf16_t*)(shm + L_OST) + wid * 2048;
#pragma unroll
                for (int r = 0; r < 16; ++r) { const int orow = crow(r, hi);
#pragma unroll
                    for (int d0 = 0; d0 < 2; ++d0) { const float v = o[d0][r] * rli[r]; const unsigned pk = cvtpk(v, v); stg[orow * 64 + d0 * 32 + r32] = (bf16_t)(pk & 0xffffu); } }
                asm volatile("s_waitcnt lgkmcnt(0)" ::: "memory");
#pragma unroll
                for (int i = 0; i < 4; ++i) { const int row = i * 8 + (lane >> 3), ch = lane & 7; const u32x4 v = *(const ATT_LAS u32x4*)(stg + row * 64 + ch * 8); *(u32x4*)(Ow + (long)row * D + ch * 8) = v; }
            }
        }
        slot = (slot == 2 * SLOTB) ? 0 : slot + SLOTB;
        if (++t == NT) { ++u; t = 0; }
    }
    asm volatile("s_waitcnt lgkmcnt(0)\n\ts_barrier" ::: "memory");
#undef ATT_DMA_C
#undef ATT_LOADQ
#undef ATT_DMA_NEXT
}
#undef ASBAR
}
constexpr int NWAVES = 8;
constexpr int BATCH = 8, SEQ = 2048, DM = 1024, NH = 16, FF = 4096, TOK = BATCH * SEQ, DEPTH = 4;
constexpr size_t MiB = 1u << 20;
constexpr size_t WS_CTL = 0, CTL_ZERO_BYTES = 1 * MiB;
constexpr size_t WS_TEXT = 1 * MiB;
constexpr size_t WS_GC = 1 * MiB + 64 * 1024;
constexpr size_t WS_SSQ = 1 * MiB + 256 * 1024;
constexpr size_t WS_ARENA = 2 * MiB, ARENA_BYTES = 24 * MiB;
constexpr size_t AR_MIX = 0, AR_WO = 6 * MiB, AR_WG = 4 * MiB, AR_W1 = 8 * MiB, AR_W2 = 16 * MiB;
constexpr size_t WS_HB = 50 * MiB;
constexpr size_t WS_BIG = 82 * MiB;
constexpr size_t WS_END = WS_BIG + 64 * pg8::PANEL_BYTES;
static_assert(WS_END <= 256 * MiB, "d_ws map");
constexpr int CW_BAR = 4096;
constexpr size_t WS_CARRY = 512 * 1024;

constexpr int RING_OFF = 0, RING_BYTES = 131072;
constexpr int LDSCTL_OFF = RING_BYTES, MISC_OFF = LDSCTL_OFF + 320;
constexpr int LDS_BYTES = 163840;
static_assert(att::L_END <= RING_BYTES, "attention scratch fits the ring region");

#define GAS __attribute__((address_space(1)))
#define LAS __attribute__((address_space(3)))
typedef unsigned short bf16;
typedef unsigned v4u __attribute__((ext_vector_type(4)));
typedef float f32x4 __attribute__((ext_vector_type(4)));
typedef GAS unsigned gu32;
#define RLX_AGENT __ATOMIC_RELAXED, __HIP_MEMORY_SCOPE_AGENT
#define LDS_WAIT() asm volatile("s_waitcnt lgkmcnt(0)" ::: "memory")
#define VM_WAIT() asm volatile("s_waitcnt vmcnt(0)" ::: "memory")
__device__ __forceinline__ unsigned f2bf(float f) { unsigned u = __builtin_bit_cast(unsigned, f); return (u + 0x7fffu + ((u >> 16) & 1u)) >> 16; }
__device__ __forceinline__ unsigned pk2(float lo, float hi) { return f2bf(lo) | (f2bf(hi) << 16); }

#define XB_TMO      128
#define XB_XCNT(j)  (256  + 64 * (j))
#define XB_XSUB(j)  (1280 + 64 * (j))
#define XB_XGEN(j)  (2304 + 64 * (j))
#define XB_TOP      3328
#define XB_TOPGEN   3392
#define XCD_BAR_WORDS 3456
#define XB_SPIN_CAP (1u << 18)
__device__ __forceinline__ unsigned xb_ld(unsigned* p)              { return __hip_atomic_load(p, __ATOMIC_RELAXED, __HIP_MEMORY_SCOPE_AGENT); }
__device__ __forceinline__ unsigned xb_add(unsigned* p, unsigned v) { return __hip_atomic_fetch_add(p, v, __ATOMIC_RELAXED, __HIP_MEMORY_SCOPE_AGENT); }
__device__ __forceinline__ unsigned xb_xcc_id() { return (unsigned)__builtin_amdgcn_s_getreg((3 << 11) | 20) & 0xFu; }
#define XB_SPIN(cond, bar) do { unsigned _sp = 0; while (cond) { __builtin_amdgcn_s_sleep(1); \
    if ((++_sp & 255u) == 0u) { if (xb_ld(&(bar)[XB_TMO])) break; if (_sp > XB_SPIN_CAP) { atomicAdd(&(bar)[XB_TMO], 1u); break; } } } } while (0)
struct XcdBarrier { unsigned* bar; unsigned x; volatile LAS unsigned* st; };
__device__ __forceinline__ XcdBarrier xcd_barrier_post(unsigned* bar, volatile LAS unsigned* st) {
    XcdBarrier b; b.bar = bar; b.x = xb_xcc_id(); b.st = st;
    if (threadIdx.x == 0) (void)xb_add(&bar[XB_XCNT(b.x)], 1u);
    return b;
}
__device__ __forceinline__ void xcd_barrier_complete(unsigned* bar, unsigned x, unsigned& nloc, unsigned& nx) {
    const unsigned G = gridDim.x * gridDim.y * gridDim.z;
    unsigned sum, cnt, mine, sp = 0u;
    for (;;) {
        sum = 0u; cnt = 0u; mine = 0u;
#pragma unroll
        for (unsigned j = 0; j < 16; ++j) { const unsigned c = xb_ld(&bar[XB_XCNT(j)]); sum += c; cnt += (c > 0u) ? 1u : 0u; mine = (j == x) ? c : mine; }
        if (sum == G) break;
        __builtin_amdgcn_s_sleep(1);
        if ((++sp & 255u) == 0u) { if (xb_ld(&bar[XB_TMO])) break; if (sp > XB_SPIN_CAP) { atomicAdd(&bar[XB_TMO], 1u); break; } }
    }
    nloc = mine > 0u ? mine : 1u; nx = cnt > 0u ? cnt : 1u;
}
__device__ __forceinline__ void xcd_barrier(const XcdBarrier& b, int wave) {
    asm volatile("s_waitcnt vmcnt(0)" ::: "memory");
    __syncthreads();
    if (pg8::tid_of(wave) == 0) {
        unsigned* bar = b.bar;
        __builtin_amdgcn_s_waitcnt(0);
        unsigned nloc = b.st[0], nx = b.st[1];
        if (nloc == 0u) { xcd_barrier_complete(bar, b.x, nloc, nx); b.st[0] = nloc; b.st[1] = nx; }
        const unsigned old = xb_add(&bar[XB_XSUB(b.x)], 1u);
        const unsigned gen = old / nloc;
        if (old + 1u == (gen + 1u) * nloc) {
            __builtin_amdgcn_fence(__ATOMIC_RELEASE, "agent");
            asm volatile("s_waitcnt vmcnt(0)" ::: "memory");
            const unsigned og = xb_add(&bar[XB_TOP], 1u);
            const unsigned tg = og / nx;
            if (og + 1u == (tg + 1u) * nx) xb_add(&bar[XB_TOPGEN], 1u);
            else XB_SPIN(xb_ld(&bar[XB_TOPGEN]) == tg, bar);
            __builtin_amdgcn_fence(__ATOMIC_ACQUIRE, "agent");
            xb_add(&bar[XB_XGEN(b.x)], 1u);
            asm volatile("s_waitcnt vmcnt(0)" ::: "memory");
        } else {
            XB_SPIN(xb_ld(&bar[XB_XGEN(b.x)]) == gen, bar);
            __builtin_amdgcn_fence(__ATOMIC_ACQUIRE, "agent");
            asm volatile("s_waitcnt vmcnt(0)" ::: "memory");
        }
    }
    __syncthreads();
}


#define GB_BASE(g)    (8192 + 1024 * (g))
#define GB_CEN(x)     (16 * (x))
#define GB_SUB(x)     (256 + 16 * (x))
#define GB_GEN(x)     (512 + 16 * (x))
#define GB_TOP        768
#define GB_TOPGEN     784
#define GB_SPIN(cond) do { unsigned _sp = 0; while (cond) { __builtin_amdgcn_s_sleep(1); if (++_sp > (1u << 22)) break; } } while (0)
__device__ __forceinline__ void group_barrier_post(unsigned* ctl, unsigned group) {
    if (threadIdx.x == 0) (void)xb_add(&ctl[GB_BASE(group) + GB_CEN(xb_xcc_id())], 1u);
}
#define GB_EVT        800
__device__ __forceinline__ void group_barrier(unsigned* ctl, unsigned group, volatile LAS unsigned* st, int wave, int dep0 = -1, int dep1 = -1, int delta = 0) {
    asm volatile("s_waitcnt vmcnt(0)" ::: "memory");
    __syncthreads();
    if (pg8::tid_of(wave) == 0) {
        unsigned* w = ctl + GB_BASE(group); const unsigned x = xb_xcc_id();
        __builtin_amdgcn_s_waitcnt(0);
        unsigned nloc = st[0], nx = st[1];
        if (nloc == 0u) { nx = 0u;
#pragma unroll
            for (unsigned j = 0; j < 16; ++j) { const unsigned c = xb_ld(&w[GB_CEN(j)]); nx += (c > 0u) ? 1u : 0u; nloc = (j == x) ? c : nloc; }
            nloc = nloc > 0u ? nloc : 1u; nx = nx > 0u ? nx : 1u; st[0] = nloc; st[1] = nx; }
        const unsigned ord = st[2] + 1u; st[2] = ord;
        const unsigned old = xb_add(&w[GB_SUB(x)], 1u);
        const unsigned gen = old / nloc;
        if (old + 1u == (gen + 1u) * nloc) {
            if (nx > 1u) {
                __builtin_amdgcn_fence(__ATOMIC_RELEASE, "agent");
                asm volatile("s_waitcnt vmcnt(0)" ::: "memory");
                const unsigned og = xb_add(&w[GB_TOP], 1u);
                const unsigned tg = og / nx;
                if (og + 1u == (tg + 1u) * nx) { xb_add(&w[GB_EVT], 1u); xb_add(&w[GB_TOPGEN], 1u); }
                else GB_SPIN(xb_ld(&w[GB_TOPGEN]) == tg);
            } else {
                xb_add(&w[GB_EVT], 1u);
            }
            if (dep0 >= 0) GB_SPIN((int)(xb_ld(&ctl[GB_BASE(dep0) + GB_EVT]) - (ord + (unsigned)delta)) < 0);
            if (dep1 >= 0) GB_SPIN((int)(xb_ld(&ctl[GB_BASE(dep1) + GB_EVT]) - (ord + (unsigned)delta)) < 0);
            __builtin_amdgcn_fence(__ATOMIC_ACQUIRE, "agent");
            xb_add(&w[GB_GEN(x)], 1u);
            asm volatile("s_waitcnt vmcnt(0)" ::: "memory");
        } else {
            GB_SPIN(xb_ld(&w[GB_GEN(x)]) == gen);
            if (dep0 >= 0) GB_SPIN((int)(xb_ld(&ctl[GB_BASE(dep0) + GB_EVT]) - (ord + (unsigned)delta)) < 0);
            if (dep1 >= 0) GB_SPIN((int)(xb_ld(&ctl[GB_BASE(dep1) + GB_EVT]) - (ord + (unsigned)delta)) < 0);
            __builtin_amdgcn_fence(__ATOMIC_ACQUIRE, "agent");
            asm volatile("s_waitcnt vmcnt(0)" ::: "memory");
        }
    }
    __syncthreads();
}
__device__ __forceinline__ bool label_one_xcc(unsigned* ctl, unsigned label) {
    unsigned nx = 0u;
#pragma unroll
    for (unsigned j = 0; j < 16; ++j) { const unsigned c = xb_ld(&ctl[GB_BASE(label) + GB_CEN(j)]); nx += (c > 0u) ? 1u : 0u; }
    return nx <= 1u;
}

__device__ __forceinline__ int opq_bx() { int b = blockIdx.x; asm volatile("" : "+s"(b)); return b; }
__device__ __forceinline__ int opq_i(int v) { asm volatile("" : "+s"(v)); return v; }
__device__ __forceinline__ unsigned char* opq_p(unsigned char* p) { unsigned long long a = (unsigned long long)p; asm volatile("" : "+s"(a)); return (unsigned char*)(GAS unsigned char*)a; }
__device__ __forceinline__ int opq_v(int v) { asm volatile("" : "+v"(v)); return v; }
struct Frame {
    LAS unsigned char* lds;
    volatile LAS unsigned* MISC;
    int tid, lane, wave, vcu, G;
    float* out; unsigned char* ws;
};
#define CAS __attribute__((address_space(4)))
__device__ __forceinline__ const float* inp(int i) {
    const CAS char* ka = (const CAS char*)__builtin_amdgcn_kernarg_segment_ptr(); asm volatile("" : "+s"(ka));
    const GAS float* p = *(const GAS float* const CAS*)(ka + 8 * i);
    return (const float*)p;
}
__device__ __forceinline__ float wave_sum(float v) {
    v += __int_as_float(__builtin_amdgcn_ds_swizzle(__float_as_int(v), 0x041F));
    v += __int_as_float(__builtin_amdgcn_ds_swizzle(__float_as_int(v), 0x081F));
    v += __int_as_float(__builtin_amdgcn_ds_swizzle(__float_as_int(v), 0x101F));
    v += __int_as_float(__builtin_amdgcn_ds_swizzle(__float_as_int(v), 0x201F));
    v += __int_as_float(__builtin_amdgcn_ds_swizzle(__float_as_int(v), 0x401F));
    const auto rr = __builtin_amdgcn_permlane32_swap(__float_as_uint(v), __float_as_uint(v), false, false);
    return __uint_as_float(rr[0]) + __uint_as_float(rr[1]);
}
__device__ __forceinline__ void transpose_item(const float* W, int N, bf16* WT, int ldo, const float* scale, LAS float* scr, int item, int nblk, int lane) {
    const int kb = item / nblk, nb = item % nblk, k0 = 64 * kb, n0 = 32 * nb;
    float v[32];
#pragma unroll
    for (int i = 0; i < 32; ++i) v[i] = __builtin_nontemporal_load(W + (size_t)(k0 + 2 * i + (lane >> 5)) * N + n0 + (lane & 31));
    if (scale) {
#pragma unroll
        for (int i = 0; i < 32; ++i) v[i] *= scale[k0 + 2 * i + (lane >> 5)]; }
#pragma unroll
    for (int i = 0; i < 32; ++i) scr[(2 * i + (lane >> 5)) * 33 + (lane & 31)] = v[i];
    LDS_WAIT(); asm volatile("" ::: "memory");
    const int c = lane & 7;
#pragma unroll
    for (int j = 0; j < 4; ++j) { const int n = (lane >> 3) + 8 * j; const LAS float* s = scr + (8 * c) * 33 + n;
        v4u o; o.x = pk2(s[0 * 33], s[1 * 33]); o.y = pk2(s[2 * 33], s[3 * 33]); o.z = pk2(s[4 * 33], s[5 * 33]); o.w = pk2(s[6 * 33], s[7 * 33]);
        *(GAS v4u*)(WT + (size_t)(n0 + n) * ldo + k0 + 8 * c) = o; }
    LDS_WAIT(); asm volatile("" ::: "memory");
}
__device__ __forceinline__ unsigned char* arena_of(Frame& F, int L) { return L < 2 ? (unsigned char*)F.out + (size_t)L * ARENA_BYTES : F.ws + WS_ARENA + (size_t)(L - 2) * ARENA_BYTES; }
constexpr int CI_W1 = (DM / 64) * (FF / 32), CI_W2 = (FF / 64) * (DM / 32);
constexpr int CI_ATT_A = (DM / 64) * (3 * DM / 32), CI_ATT_B = (DM / 64) * (DM / 32), CI_ATT = CI_ATT_A + CI_ATT_B + CI_W1 + CI_W2;
constexpr int CI_REC_A = (DM / 64) * (2 * DM / 32), CI_REC_G = 512, CI_REC_B = (DM / 64) * (DM / 32), CI_REC = CI_REC_A + CI_REC_G + CI_REC_B + CI_W1 + CI_W2;
struct ConvPtrs { const float *nmix, *nmlp, *wqkv, *wo, *win, *cw, *wga, *wgx, *wro, *w1, *w2; };
__device__ __forceinline__ void convert_item(Frame& F, const ConvPtrs& P, int L, int r, LAS float* scr) {
    const int j = L >> 1;
    unsigned char* ar = arena_of(F, L);
    const float* w1 = P.w1 + (size_t)L * DM * FF; const float* w2 = P.w2 + (size_t)L * FF * DM;
    const float* gmix = P.nmix + L * DM; const float* gmlp = P.nmlp + L * DM;
    if ((L & 1) == 0) {
        const float* wqkv = P.wqkv + (size_t)j * DM * 3 * DM; const float* wo = P.wo + (size_t)j * DM * DM;
        if (r < CI_ATT_A) { transpose_item(wqkv, 3 * DM, (bf16*)(ar + AR_MIX), DM, gmix, scr, r, 3 * DM / 32, F.lane); return; } r -= CI_ATT_A;
        if (r < CI_ATT_B) { transpose_item(wo, DM, (bf16*)(ar + AR_WO), DM, nullptr, scr, r, DM / 32, F.lane); return; } r -= CI_ATT_B;
    } else {
        const float* win = P.win + (size_t)j * DM * 2 * DM; const float* wro = P.wro + (size_t)j * DM * DM;
        const float* wga = P.wga + (size_t)j * 8 * 128 * 128; const float* wgx = P.wgx + (size_t)j * 8 * 128 * 128; const float* cw = P.cw + (size_t)j * 4 * DM;
        if (r < CI_REC_A) { transpose_item(win, 2 * DM, (bf16*)(ar + AR_MIX), DM, gmix, scr, r, 2 * DM / 32, F.lane); return; } r -= CI_REC_A;
        if (r < CI_REC_G) { const int sub = r & 7, q = r >> 3, tap = q & 3, gate = (q >> 2) & 1, n = q >> 3;
            transpose_item((gate ? wgx : wga) + (size_t)n * 128 * 128, 128, (bf16*)(ar + AR_WG) + (size_t)(n * 256 + gate * 128) * 512 + tap * 128, 512, cw + tap * DM + n * 128, scr, sub, 4, F.lane); return; } r -= CI_REC_G;
        if (r < CI_REC_B) { transpose_item(wro, DM, (bf16*)(ar + AR_WO), DM, nullptr, scr, r, DM / 32, F.lane); return; } r -= CI_REC_B;
    }
    if (r < CI_W1) { transpose_item(w1, FF, (bf16*)(ar + AR_W1), DM, gmlp, scr, r, FF / 32, F.lane); return; } r -= CI_W1;
    transpose_item(w2, DM, (bf16*)(ar + AR_W2), FF, nullptr, scr, r, DM / 32, F.lane);
}
__device__ __forceinline__ void convert_all(Frame& F) {
    LAS float* scr = (LAS float*)(F.lds + RING_OFF + F.wave * 16384);
    const int gw = F.vcu * NWAVES + F.wave, NGW = F.G * NWAVES;
    const ConvPtrs P{inp(1), inp(2), inp(3), inp(4), inp(6), inp(8), inp(10), inp(12), inp(15), inp(17), inp(18)};
    for (int it = gw; it < 2 * (CI_ATT + CI_REC); it += NGW) {
        const int pair = it / (CI_ATT + CI_REC), r = it % (CI_ATT + CI_REC);
        if (r < CI_ATT) convert_item(F, P, 2 * pair, r, scr); else convert_item(F, P, 2 * pair + 1, r - CI_ATT, scr);
    }
}
__device__ __forceinline__ void p0_prologue(Frame& F) {
    convert_all(F);
    const int gt = F.vcu * (NWAVES * 64) + F.tid;
    if (gt < 2 * NH * 320) {
        const int i = gt % 320, jh = gt / 320; const float* rel = inp(5);
        ((float*)(F.ws + WS_TEXT))[gt] = rel[(size_t)jh * 257 + (i < 256 ? i : 256)] * 1.4426950408889634f;
    } else if (gt >= 16384 && gt < 16384 + 2 * DM) {
        const int q = gt - 16384, j = q >> 10, ch = q & 1023, n = ch >> 7, e = ch & 127;
        const float* cb = inp(9) + j * DM; const float* cw = inp(8) + (size_t)j * 4 * DM;
        const float* wga = inp(10) + ((size_t)j * 8 + n) * 128 * 128; const float* wgx = inp(12) + ((size_t)j * 8 + n) * 128 * 128;
        float sa = inp(11)[j * DM + ch], sx = inp(13)[j * DM + ch];
        for (int c = 0; c < 128; ++c) { const float cv = cb[n * 128 + c]; sa += cv * wga[c * 128 + e]; sx += cv * wgx[c * 128 + e]; }
        const float Lp = inp(14)[j * DM + ch];
        float* g = (float*)(F.ws + WS_GC) + (size_t)q * 8;
        g[0] = sa; g[1] = sx; g[2] = cb[ch]; g[3] = -8.0f * log1pf(expf(-Lp)) * 1.4426950408889634f;
        g[4] = cw[ch]; g[5] = cw[DM + ch]; g[6] = cw[2 * DM + ch]; g[7] = cw[3 * DM + ch];
    }
    const int gw = F.vcu * NWAVES + F.wave, NGW = F.G * NWAVES;
    const float* x = inp(0); bf16* hb = (bf16*)(F.ws + WS_HB); float* ssq = (float*)(F.ws + WS_SSQ);
    for (int m = gw; m < TOK; m += NGW) {
        const GAS f32x4* xr = (const GAS f32x4*)(x + (size_t)m * DM) + F.lane;
        f32x4 v[4]; float s = 0.f;
#pragma unroll
        for (int jj = 0; jj < 4; ++jj) { v[jj] = xr[64 * jj]; s += (v[jj].x * v[jj].x + v[jj].y * v[jj].y) + (v[jj].z * v[jj].z + v[jj].w * v[jj].w); }
        s = wave_sum(s);
        bf16* hp = hb + (size_t)(m >> 8) * (256 * DM) + (size_t)(m & 255) * 64;
#pragma unroll
        for (int jj = 0; jj < 4; ++jj) *(GAS unsigned long long*)(hp + (size_t)((F.lane >> 4) + 4 * jj) * pg8::KT + 4 * (F.lane & 15)) = (unsigned long long)pk2(v[jj].x, v[jj].y) | ((unsigned long long)pk2(v[jj].z, v[jj].w) << 32);
        if (F.lane < 4) ssq[(size_t)F.lane * TOK + m] = (F.lane == 0) ? s : 0.f;
    }
}
__device__ __forceinline__ void final_norm(Frame& F) {
    const int gw = F.vcu * NWAVES + F.wave, NGW = F.G * NWAVES; const float* gf = inp(19); const bf16* hb = (const bf16*)(F.ws + WS_HB);
    f32x4 g[4];
#pragma unroll
    for (int jj = 0; jj < 2; ++jj) { g[2 * jj] = *(const f32x4*)(gf + 512 * jj + 8 * F.lane); g[2 * jj + 1] = *(const f32x4*)(gf + 512 * jj + 8 * F.lane + 4); }
    for (int m = gw; m < TOK; m += NGW) {
        f32x4 v[4]; float s = 0.f;
#pragma unroll
        for (int jj = 0; jj < 2; ++jj) { const v4u r = *(const GAS v4u*)(hb + (size_t)(m >> 8) * (256 * DM) + (size_t)((F.lane >> 3) + 8 * jj) * pg8::KT + (size_t)(m & 255) * 64 + 8 * (F.lane & 7));
            v[2 * jj] = (f32x4){pg8::bf_lo(r.x), pg8::bf_hi(r.x), pg8::bf_lo(r.y), pg8::bf_hi(r.y)}; v[2 * jj + 1] = (f32x4){pg8::bf_lo(r.z), pg8::bf_hi(r.z), pg8::bf_lo(r.w), pg8::bf_hi(r.w)}; }
#pragma unroll
        for (int q = 0; q < 4; ++q) s += (v[q].x * v[q].x + v[q].y * v[q].y) + (v[q].z * v[q].z + v[q].w * v[q].w);
        const float rstd = __builtin_amdgcn_rsqf(wave_sum(s) * (1.0f / DM) + 1e-6f);
#pragma unroll
        for (int jj = 0; jj < 2; ++jj) { GAS f32x4* o = (GAS f32x4*)(F.out + (size_t)m * DM + 512 * jj + 8 * F.lane); o[0] = v[2 * jj] * rstd * g[2 * jj]; o[1] = v[2 * jj + 1] * rstd * g[2 * jj + 1]; }
    }
}
__device__ __forceinline__ void scan_phase(Frame& F, unsigned char* big, const float* gc, unsigned* carry  ) {
    LAS float* sA = (LAS float*)(F.lds + att::L_TAB);
    LAS float* sH = sA + 1024;
    LAS unsigned* sB = (LAS unsigned*)(F.lds + RING_OFF);
    const int tid = opq_v(pg8::tid_of(F.wave)); const int b = (int)((unsigned)opq_bx() & 7u), p = (int)(((unsigned)opq_bx() >> 3) & 7u), m = (int)((unsigned)opq_bx() >> 6);
    const int cp = tid & 127, seg = tid >> 7;
    const int ch = (cp < 64 ? 128 * m : 384 + 128 * m) + 2 * cp;
    const f32x4 k0a = *(const f32x4*)(gc + (size_t)ch * 8), k0b = *(const f32x4*)(gc + (size_t)ch * 8 + 4), k1a = *(const f32x4*)(gc + (size_t)(ch + 1) * 8), k1b = *(const f32x4*)(gc + (size_t)(ch + 1) * 8 + 4);
    const float cb0 = k0a[2], cb1 = k1a[2];
    const unsigned char* pan = big + (size_t)(b * 8 + p) * pg8::PANEL_BYTES;
    const unsigned eo = (unsigned)(((ch >> 6) * pg8::KT + (seg * 64) * 64 + (ch & 63)) * 2), eox = (unsigned)(((ch >> 6) * pg8::KTX + (seg * 64) * 64 + (ch & 63)) * 2);
    const unsigned char* pan_a = pan + pg8::PO_AL; const unsigned char* pan_b = pan + pg8::PO_BQ; const unsigned char* pan_y = pan + pg8::PO_Y; const unsigned char* pan_x = pan + pg8::PO_X;
#define SC_LD(base_, off_, row_) (*(const unsigned*)((base_) + (size_t)(off_) + (size_t)(row_) * 128))
    unsigned ua[64];
#pragma unroll
    for (int s = 0; s < 64; ++s) ua[s] = SC_LD(pan_a, eo, s);
    unsigned xw0 = SC_LD(pan_x, eox, 0), xw1 = SC_LD(pan_x, eox, 1), xw2 = SC_LD(pan_x, eox, 2);
    float A0 = 1.f, A1 = 1.f, H0 = 0.f, H1 = 0.f;
#pragma unroll
    for (int c = 0; c < 4; ++c) {
        unsigned ub[16], ux[16];
#pragma unroll
        for (int s = 0; s < 16; ++s) { ub[s] = SC_LD(pan_b, eo, 16 * c + s); ux[s] = SC_LD(pan_x, eox, 16 * c + s + 3); }
#pragma unroll
        for (int s = 0; s < 16; ++s) {
            const float a0 = __builtin_amdgcn_exp2f(pg8::bf_lo(ua[16 * c + s])), a1 = __builtin_amdgcn_exp2f(pg8::bf_hi(ua[16 * c + s]));
            const float xc0 = cb0 + k0b[0] * pg8::bf_lo(xw0) + k0b[1] * pg8::bf_lo(xw1) + k0b[2] * pg8::bf_lo(xw2) + k0b[3] * pg8::bf_lo(ux[s]);
            const float xc1 = cb1 + k1b[0] * pg8::bf_hi(xw0) + k1b[1] * pg8::bf_hi(xw1) + k1b[2] * pg8::bf_hi(xw2) + k1b[3] * pg8::bf_hi(ux[s]);
            xw0 = xw1; xw1 = xw2; xw2 = ux[s];
            const unsigned bp = pg8::cvt_pk_bf16(pg8::bf_lo(ub[s]) * xc0, pg8::bf_hi(ub[s]) * xc1);
            sB[(16 * c + s) * 512 + tid] = bp;
            H0 = a0 * H0 + pg8::bf_lo(bp); H1 = a1 * H1 + pg8::bf_hi(bp); A0 *= a0; A1 *= a1; }
        asm volatile("" ::: "memory");
    }
#pragma unroll
    for (int s = 0; s < 64; ++s) asm volatile("" : "+v"(ua[s]));
    unsigned uy[16];
#pragma unroll
    for (int s = 0; s < 16; ++s) uy[s] = SC_LD(pan_y, eo, s);
    sA[seg * 256 + 2 * cp] = A0; sA[seg * 256 + 2 * cp + 1] = A1; sH[seg * 256 + 2 * cp] = H0; sH[seg * 256 + 2 * cp + 1] = H1;
    asm volatile("s_waitcnt lgkmcnt(0)\n\ts_barrier" ::: "memory");
    float c0 = 0.f, c1 = 0.f;
    const int chl = (cp < 64 ? 128 * m : 384 + 128 * m) + 2 * cp;
    if (p > 0) {
        const unsigned long long* gin = (const unsigned long long*)(carry + ((size_t)b * 7 + (p - 1)) * 1024 + chl);
        unsigned long long w = 0ull; unsigned sp = 0;
        while (true) { w = __hip_atomic_load(gin, __ATOMIC_RELAXED, __HIP_MEMORY_SCOPE_AGENT); if (((unsigned)w != 0u) && ((unsigned)(w >> 32) != 0u)) break; __builtin_amdgcn_s_sleep(1); if (++sp > (1u << 22)) break; }
        c0 = __uint_as_float((unsigned)w); c1 = __uint_as_float((unsigned)(w >> 32));
    }
    for (int s2 = 0; s2 < seg; ++s2) { c0 = sA[s2 * 256 + 2 * cp] * c0 + sH[s2 * 256 + 2 * cp]; c1 = sA[s2 * 256 + 2 * cp + 1] * c1 + sH[s2 * 256 + 2 * cp + 1]; }
    if (seg == 3 && p < 7) {
        const float e0 = A0 * c0 + H0, e1 = A1 * c1 + H1;
        const unsigned long long w = (unsigned long long)(__float_as_uint(e0) | 1u) | ((unsigned long long)(__float_as_uint(e1) | 1u) << 32);
        __hip_atomic_store((unsigned long long*)(carry + ((size_t)b * 7 + p) * 1024 + chl), w, __ATOMIC_RELAXED, __HIP_MEMORY_SCOPE_AGENT);
    }
    unsigned char* pan_g = (unsigned char*)pan + pg8::PO_G;
#pragma unroll
    for (int c = 0; c < 4; ++c) {
        unsigned un[16];
        if (c < 3) {
#pragma unroll
            for (int s = 0; s < 16; ++s) un[s] = SC_LD(pan_y, eo, 16 * c + 16 + s); }
#pragma unroll
        for (int s = 0; s < 16; ++s) {
            const float a0 = __builtin_amdgcn_exp2f(pg8::bf_lo(ua[16 * c + s])), a1 = __builtin_amdgcn_exp2f(pg8::bf_hi(ua[16 * c + s]));
            const unsigned bp = sB[(16 * c + s) * 512 + tid];
            c0 = a0 * c0 + pg8::bf_lo(bp); c1 = a1 * c1 + pg8::bf_hi(bp);
            *(unsigned*)(pan_g + (size_t)eo + (size_t)(16 * c + s) * 128) = pg8::cvt_pk_bf16(c0 * pg8::bf_lo(uy[s]), c1 * pg8::bf_hi(uy[s])); }
        asm volatile("" ::: "memory");
        if (c < 3) {
#pragma unroll
            for (int s = 0; s < 16; ++s) uy[s] = un[s]; }
    }
    asm volatile("s_waitcnt lgkmcnt(0)\n\ts_barrier" ::: "memory");
#undef SC_LD
}

struct Args { const float* in[20]; float* out; unsigned char* ws; int n_sub; int pad; };
__global__ void __launch_bounds__(NWAVES * 64, 2) mega_fwd(Args args) {
    extern __shared__ __attribute__((aligned(16))) unsigned char lds[];
    Frame F;
    F.lds = (LAS unsigned char*)lds;
    F.MISC = (volatile LAS unsigned*)(F.lds + MISC_OFF);
    F.tid = threadIdx.x; F.lane = F.tid & 63; F.wave = __builtin_amdgcn_readfirstlane(F.tid >> 6);
    F.G = gridDim.x; { const int bx = blockIdx.x; F.vcu = (F.G % 8 == 0) ? (bx % 8) * (F.G / 8) + bx / 8 : bx; }
    F.out = args.out; F.ws = args.ws;
    unsigned char* ws = args.ws;
    for (int u = F.tid; u < (LDS_BYTES - LDSCTL_OFF) / 4; u += NWAVES * 64) ((LAS unsigned*)(F.lds + LDSCTL_OFF))[u] = 0u;
    __syncthreads();
    XcdBarrier bar = xcd_barrier_post((unsigned*)(ws + WS_CTL) + CW_BAR, F.MISC + 8);
#define GRID_BAR() xcd_barrier(bar, F.wave)
    group_barrier_post((unsigned*)(ws + WS_CTL), blockIdx.x & 7u);
    group_barrier_post((unsigned*)(ws + WS_CTL), 8u + (blockIdx.x & 7u) * 8u + ((blockIdx.x >> 3) & 7u));
#define P_LABEL ((unsigned)opq_bx() & 7u)
#define P_QUAD (((unsigned)opq_bx() >> 3) & 7u)
#define QGROUP(p_) (8u + P_LABEL * 8u + (unsigned)(p_))
#define CTLW ((unsigned*)(ws_ + WS_CTL))
#define GROUP_BAR() group_barrier(CTLW, P_LABEL, F.MISC + 10, F.wave)
#define QUAD_BAR() group_barrier(CTLW, QGROUP(P_QUAD), F.MISC + 13, F.wave)
#define CAUSAL_BAR(D2) do { if (fastdf) { const int pq_ = (int)P_QUAD; group_barrier(CTLW, QGROUP(pq_), F.MISC + 13, F.wave, pq_ >= 1 ? (int)QGROUP(pq_ - 1) : -1, ((D2) && pq_ >= 2) ? (int)QGROUP(pq_ - 2) : -1, 0); } else GROUP_BAR(); } while (0)
#define QUADL_BAR() do { if (fastdf) QUAD_BAR(); else GROUP_BAR(); } while (0)
#define QUAD_BAR_WAR() do { if (fastdf) { const int pq_ = (int)P_QUAD; group_barrier(CTLW, QGROUP(pq_), F.MISC + 13, F.wave, pq_ + 1 < 8 ? (int)QGROUP(pq_ + 1) : -1, pq_ + 2 < 8 ? (int)QGROUP(pq_ + 2) : -1, -1); } else QUAD_BAR(); } while (0)


    p0_prologue(F);
    GRID_BAR();
    const int fast0 = __builtin_amdgcn_readfirstlane(label_one_xcc((unsigned*)(ws + WS_CTL), blockIdx.x & 7u) ? 1 : 0);

    const int n_sub = args.n_sub;
    for (int sub = 0; sub < n_sub; ++sub) {
        const int L = sub >> 1, j = L >> 1;
        F.vcu = opq_i(F.vcu);
        unsigned char* ws_ = opq_p(args.ws);
        bf16* HB = (bf16*)(ws_ + WS_HB); float* SSQ = (float*)(ws_ + WS_SSQ); unsigned char* BIG = ws_ + WS_BIG;
        unsigned char* ar = arena_of(F, L);
        const bool fastdf = fast0 != 0;
        pg8::Gemm gr; const float* rbias = nullptr; bool war = false;
        if ((sub & 1) == 0) {
            if ((L & 1) == 0) {
                { pg8::Gemm g{(const char*)HB, (size_t)256 * DM * 2, (const bf16*)(ar + AR_MIX), DM, 64, 32768}; pg8::StaticOrder S; S.init(TOK, 3 * DM, F.G, opq_bx());
                  pg8::EpiQKV E{BIG, SSQ};
                  pg8::gemm_phase<pg8::EpiQKV, 0, true, true>(F.lds + RING_OFF, g, S, E, F.wave); }
                CAUSAL_BAR(1);
                { const int h0 = (int)((unsigned)opq_bx() >> 6) * 4; const float* tab = (const float*)(ws_ + WS_TEXT) + ((size_t)j * NH + h0) * 320;
                  att::attn_tables(tab, F.lds + RING_OFF, F.wave);
                  att::attn_stream((int)P_LABEL, (int)P_QUAD, h0, BIG, F.lds + RING_OFF, F.wave); }
                QUADL_BAR();
                war = true;
                gr = pg8::Gemm{(const char*)(BIG + pg8::PO_O), pg8::PANEL_BYTES, (const bf16*)(ar + AR_WO), DM, 64, 32768};
            } else {
                if (opq_bx() < BATCH) { const int tz = pg8::tid_of(F.wave); if (tz < 384) { const unsigned z = (unsigned)opq_v(0);
                    *(GAS v4u*)((bf16*)(BIG + (size_t)(opq_bx() * 8) * pg8::PANEL_BYTES + pg8::PO_X) + (size_t)(tz / 24) * pg8::KTX + (tz % 24) * 8) = (v4u){z, z, z, z}; } }
                { pg8::Gemm g{(const char*)HB, (size_t)256 * DM * 2, (const bf16*)(ar + AR_MIX), DM, 64, 32768}; pg8::StaticOrder S; S.init(TOK, 2 * DM, F.G, opq_bx());
                  pg8::EpiIn E{BIG, SSQ, inp(7) + (size_t)j * 2 * DM};
                  pg8::gemm_phase<pg8::EpiIn, 0, true, true>(F.lds + RING_OFF, g, S, E, F.wave); }
                CAUSAL_BAR(0);
                { pg8::Gemm g{(const char*)(BIG + pg8::PO_X), pg8::PANEL_BYTES, (const bf16*)(ar + AR_WG), 512, 64, 0}; pg8::StaticOrder S; S.init(TOK, 2 * DM, F.G, opq_bx());
                  pg8::EpiGate E{BIG, (const float*)(ws_ + WS_GC) + (size_t)j * DM * 8};
                  pg8::gemm_phase<pg8::EpiGate, 1, true, true>(F.lds + RING_OFF, g, S, E, F.wave); }
                asm volatile("s_waitcnt vmcnt(0)" ::: "memory"); __syncthreads();
                scan_phase(F, BIG, (const float*)(ws_ + WS_GC) + (size_t)j * DM * 8, (unsigned*)(ws_ + WS_CARRY) + (size_t)j * 8 * 7 * 1024);
                QUAD_BAR();
                gr = pg8::Gemm{(const char*)(BIG + pg8::PO_G), pg8::PANEL_BYTES, (const bf16*)(ar + AR_WO), DM, 64, 32768}; rbias = inp(16) + (size_t)j * DM;
            }
        } else {
            { pg8::Gemm g{(const char*)HB, (size_t)256 * DM * 2, (const bf16*)(ar + AR_W1), DM, 64, 32768}; pg8::StaticOrder S; S.init(TOK, FF, F.G, opq_bx());
              pg8::EpiUp E{BIG, SSQ};
              pg8::gemm_phase<pg8::EpiUp, 0, true, true>(F.lds + RING_OFF, g, S, E, F.wave); }
            QUAD_BAR();
            gr = pg8::Gemm{(const char*)(BIG + pg8::PO_Z), pg8::PANEL_BYTES, (const bf16*)(ar + AR_W2), FF, 64, 32768};
        }
        { pg8::StaticOrder S; S.init(TOK, DM, F.G, opq_bx());
          pg8::EpiRes E{HB, SSQ, rbias};
          pg8::gemm_phase<pg8::EpiRes, 0, false, true>(F.lds + RING_OFF, gr, S, E, F.wave); }
        if (war) QUAD_BAR_WAR(); else QUAD_BAR();
    }
    GRID_BAR();
    F.tid = pg8::tid_of(F.wave); F.lane = F.tid & 63;
    if (n_sub == 2 * DEPTH) { final_norm(F); }
}

#if FAST_SUBS < 8
namespace nv {
constexpr int D = 1024, B = 8, S = 2048, DEPTH = 4, H = 16, HD = 64, CH = 64, LEFT = 8, BAND = 9 * 64, MAXREL = 128, NREL = 257;
constexpr int DR = 1024, NB = 8, RB = 128, FF = 4096;

__global__ void rmsnorm_k(const float* x, const float* __restrict__ g, float* y) {
    const int row = blockIdx.x, tid = threadIdx.x;
    const float* xr = x + (size_t)row * D;
    float v[4], s = 0.f;
#pragma unroll
    for (int i = 0; i < 4; ++i) { v[i] = xr[tid + 256 * i]; s += v[i] * v[i]; }
    __shared__ float red[256];
    red[tid] = s; __syncthreads();
    for (int o = 128; o > 0; o >>= 1) { if (tid < o) red[tid] += red[tid + o]; __syncthreads(); }
    const float rstd = rsqrtf(red[0] / D + 1e-6f);
#pragma unroll
    for (int i = 0; i < 4; ++i) y[(size_t)row * D + tid + 256 * i] = v[i] * rstd * g[tid + 256 * i];
}

__global__ void gemm_k(const float* __restrict__ A, int lda, const float* __restrict__ Bm, int ldb, float* C, int ldc,
                       const float* __restrict__ bias, const float* res, int ldr, int K, int act) {
    __shared__ float As[16][64 + 1], Bs[16][64 + 1];
    const int tx = threadIdx.x & 15, ty = threadIdx.x >> 4, m0 = blockIdx.y * 64, n0 = blockIdx.x * 64;
    float acc[4][4] = {};
    for (int k0 = 0; k0 < K; k0 += 16) {
        for (int i = threadIdx.x; i < 64 * 16; i += 256) { const int r = i >> 4, c = i & 15; As[c][r] = A[(size_t)(m0 + r) * lda + k0 + c]; }
        for (int i = threadIdx.x; i < 16 * 64; i += 256) { const int r = i >> 6, c = i & 63; Bs[r][c] = Bm[(size_t)(k0 + r) * ldb + n0 + c]; }
        __syncthreads();
#pragma unroll
        for (int kk = 0; kk < 16; ++kk) {
            float a[4], b[4];
#pragma unroll
            for (int i = 0; i < 4; ++i) { a[i] = As[kk][ty * 4 + i]; b[i] = Bs[kk][tx * 4 + i]; }
#pragma unroll
            for (int i = 0; i < 4; ++i)
#pragma unroll
                for (int j = 0; j < 4; ++j) acc[i][j] += a[i] * b[j];
        }
        __syncthreads();
    }
#pragma unroll
    for (int i = 0; i < 4; ++i)
#pragma unroll
        for (int j = 0; j < 4; ++j) {
            const int r = m0 + ty * 4 + i, c = n0 + tx * 4 + j;
            float v = acc[i][j];
            if (bias) v += bias[c];
            if (act == 1) { v = fmaxf(v, 0.f); v = v * v; }
            if (res) v += res[(size_t)r * ldr + c];
            C[(size_t)r * ldc + c] = v;
        }
}

__global__ void __launch_bounds__(64) attn_k(const float* __restrict__ qkv, const float* __restrict__ table, float* __restrict__ o) {
    const int c = blockIdx.x, h = blockIdx.y, qi = threadIdx.x, t = c * CH + qi;
    float q[HD], acc[HD];
#pragma unroll
    for (int d = 0; d < HD; ++d) { q[d] = qkv[(size_t)t * 3 * D + h * HD + d]; acc[d] = 0.f; }
    const int k0 = c * CH - LEFT * CH;
    float m = -1e30f;
    for (int j = 0; j < BAND; ++j) {
        const int kp = k0 + j; if (kp < 0) continue;
        const float* kr = qkv + (size_t)kp * 3 * D + D + h * HD;
        float s = 0.f;
    #pragma unroll
    for (int d = 0; d < HD; ++d) s += q[d] * kr[d];
        int rel = t - kp; rel = rel < -MAXREL ? -MAXREL : (rel > MAXREL ? MAXREL : rel);
        s = s * 0.125f + table[h * NREL + rel + MAXREL];
        m = fmaxf(m, s);
    }
    float l = 0.f;
    for (int j = 0; j < BAND; ++j) {
        const int kp = k0 + j; if (kp < 0) continue;
        const float* kr = qkv + (size_t)kp * 3 * D + D + h * HD;
        const float* vr = qkv + (size_t)kp * 3 * D + 2 * D + h * HD;
        float s = 0.f;
    #pragma unroll
    for (int d = 0; d < HD; ++d) s += q[d] * kr[d];
        int rel = t - kp; rel = rel < -MAXREL ? -MAXREL : (rel > MAXREL ? MAXREL : rel);
        s = s * 0.125f + table[h * NREL + rel + MAXREL];
        const float p = expf(s - m);
        l += p;
    #pragma unroll
    for (int d = 0; d < HD; ++d) acc[d] += p * vr[d];
    }
    const float il = 1.f / l;
#pragma unroll
    for (int d = 0; d < HD; ++d) o[(size_t)t * D + h * HD + d] = acc[d] * il;
}

__global__ void conv_k(const float* __restrict__ u, const float* __restrict__ cw, const float* __restrict__ cb, float* __restrict__ xc) {
    const int t = blockIdx.x;
    for (int ch = threadIdx.x; ch < DR; ch += 256) {
        float v = cb[ch];
        for (int tap = 0; tap < 4; ++tap) { const int tt = t - 3 + tap; if (tt >= 0) v += u[(size_t)tt * 2 * DR + ch] * cw[tap * DR + ch]; }
        xc[(size_t)t * DR + ch] = v;
    }
}

__global__ void gates_k(const float* __restrict__ xc, const float* __restrict__ wga, const float* __restrict__ bga, const float* __restrict__ wgx,
                        const float* __restrict__ bgx, const float* __restrict__ ap, float* __restrict__ a, float* __restrict__ bq) {
    const int t = blockIdx.x;
    __shared__ float xr[DR];
    for (int i = threadIdx.x; i < DR; i += 256) xr[i] = xc[(size_t)t * DR + i];
    __syncthreads();
    for (int e = threadIdx.x; e < DR; e += 256) {
        const int n = e / RB, ee = e % RB;
        float sa = bga[e], sx = bgx[e];
        for (int c2 = 0; c2 < RB; ++c2) { const float xv = xr[n * RB + c2]; sa += xv * wga[((size_t)n * RB + c2) * RB + ee]; sx += xv * wgx[((size_t)n * RB + c2) * RB + ee]; }
        const float r = 1.f / (1.f + expf(-sa)), ig = 1.f / (1.f + expf(-sx));
        const float L = ap[e];
        const float sp = log1pf(expf(-L));
        const float log_a = -8.f * r * sp;
        const float av = expf(log_a);
        const float mult = sqrtf(-expm1f(2.f * log_a));
        a[(size_t)t * DR + e] = av;
        bq[(size_t)t * DR + e] = mult * (ig * xr[e]);
    }
}

__global__ void scan_k(const float* __restrict__ a, const float* __restrict__ bq, const float* __restrict__ u, float* __restrict__ out) {
    const int ch = blockIdx.x * blockDim.x + threadIdx.x;
    float hs = 0.f;
    for (int t = 0; t < S; ++t) {
        hs = a[(size_t)t * DR + ch] * hs + bq[(size_t)t * DR + ch];
        const float y = u[(size_t)t * 2 * DR + DR + ch];
        const float gy = 0.5f * y * (1.f + tanhf(0.7978845608028654f * (y + 0.044715f * y * y * y)));
        out[(size_t)t * DR + ch] = hs * gy;
    }
}
}
#endif
#if FAST_SUBS < 8
__global__ void dbg_bf2f(const unsigned short* in, float* out, size_t n) { for (size_t i = (size_t)blockIdx.x * blockDim.x + threadIdx.x; i < n; i += (size_t)gridDim.x * blockDim.x) { const size_t m = i >> 10, c = i & 1023; out[i] = __uint_as_float((unsigned)in[(m >> 8) * (256 * 1024) + (c >> 6) * (256 * 64) + (m & 255) * 64 + (c & 63)] << 16); } }
#endif
extern "C" void kernel_launch(void* const* d_in, const int* in_sizes, int n_in, void* d_out, int out_size, void* d_ws, size_t ws_size, hipStream_t stream) {
    static int grid = 0;
    if (grid == 0) {
        int dev = 0, cus = 0;
        if (n_in != 20 || out_size != TOK * DM || ws_size < WS_END) { fprintf(stderr, "kernel_launch: unexpected shapes (n_in %d out %d ws %zu)\n", n_in, out_size, ws_size); grid = -1; return; }
        if (hipGetDevice(&dev) != hipSuccess || hipDeviceGetAttribute(&cus, hipDeviceAttributeMultiprocessorCount, dev) != hipSuccess) { grid = -1; return; }
        if (hipFuncSetAttribute((const void*)mega_fwd, hipFuncAttributeMaxDynamicSharedMemorySize, LDS_BYTES) != hipSuccess) { fprintf(stderr, "kernel_launch: hipFuncSetAttribute failed\n"); grid = -1; return; }
        (void)hipGetLastError();
        grid = cus;
        if (grid != 256) fprintf(stderr, "kernel_launch: %d CUs; this kernel is built for 256\n", grid);
    }
    if (grid < 0) return;
    (void)hipMemsetAsync((char*)d_ws + WS_CTL, 0, CTL_ZERO_BYTES, stream);
    Args a{};
    for (int i = 0; i < 20; ++i) a.in[i] = (const float*)d_in[i];
    a.out = (float*)d_out; a.ws = (unsigned char*)d_ws; a.n_sub = FAST_SUBS; a.pad = 0;
    hipLaunchKernelGGL(mega_fwd, dim3(grid), dim3(NWAVES * 64), LDS_BYTES, stream, a);
#if FAST_SUBS < 8
    {
        using namespace nv;
        const float* norm_mix = (const float*)d_in[1]; const float* norm_mlp = (const float*)d_in[2];
        const float* w_qkv = (const float*)d_in[3]; const float* w_o = (const float*)d_in[4]; const float* rel = (const float*)d_in[5];
        const float* r_win = (const float*)d_in[6]; const float* r_bin = (const float*)d_in[7]; const float* r_cw = (const float*)d_in[8]; const float* r_cb = (const float*)d_in[9];
        const float* r_wga = (const float*)d_in[10]; const float* r_bga = (const float*)d_in[11]; const float* r_wgx = (const float*)d_in[12]; const float* r_bgx = (const float*)d_in[13];
        const float* r_ap = (const float*)d_in[14]; const float* r_wo = (const float*)d_in[15]; const float* r_bo = (const float*)d_in[16];
        const float* w1 = (const float*)d_in[17]; const float* w2 = (const float*)d_in[18]; const float* norm_final = (const float*)d_in[19];
        float* h = (float*)d_out; float* wsf = (float*)((char*)d_ws + 64 * MiB);
        float* hn = wsf; float* big = hn + (size_t)S * D; float* t1 = big + (size_t)S * FF; float* t2 = t1 + (size_t)S * D; float* t3 = t2 + (size_t)S * D;
        if (FAST_SUBS == 0) (void)hipMemcpyAsync(h, d_in[0], (size_t)B * S * D * 4, hipMemcpyDeviceToDevice, stream);
        else dbg_bf2f<<<4096, 256, 0, stream>>>((const unsigned short*)((char*)d_ws + WS_HB), h, (size_t)B * S * D);
        for (int sub = FAST_SUBS; sub < 8; ++sub) {
            const int layer = sub >> 1, j = layer / 2;
            for (int b = 0; b < B; ++b) {
                float* hb = h + (size_t)b * S * D;
                if ((sub & 1) == 0) {
                    rmsnorm_k<<<S, 256, 0, stream>>>(hb, norm_mix + layer * D, hn);
                    if (layer % 2 == 0) {
                        gemm_k<<<dim3(3 * D / 64, S / 64), 256, 0, stream>>>(hn, D, w_qkv + (size_t)j * D * 3 * D, 3 * D, big, 3 * D, nullptr, nullptr, 0, D, 0);
                        attn_k<<<dim3(S / CH, H), 64, 0, stream>>>(big, rel + (size_t)j * H * NREL, t1);
                        gemm_k<<<dim3(D / 64, S / 64), 256, 0, stream>>>(t1, D, w_o + (size_t)j * D * D, D, hb, D, nullptr, hb, D, D, 0);
                    } else {
                        gemm_k<<<dim3(2 * DR / 64, S / 64), 256, 0, stream>>>(hn, D, r_win + (size_t)j * D * 2 * DR, 2 * DR, big, 2 * DR, r_bin + (size_t)j * 2 * DR, nullptr, 0, D, 0);
                        conv_k<<<S, 256, 0, stream>>>(big, r_cw + (size_t)j * 4 * DR, r_cb + (size_t)j * DR, t1);
                        gates_k<<<S, 256, 0, stream>>>(t1, r_wga + (size_t)j * NB * RB * RB, r_bga + (size_t)j * DR, r_wgx + (size_t)j * NB * RB * RB, r_bgx + (size_t)j * DR, r_ap + (size_t)j * DR, t2, t3);
                        scan_k<<<DR / 64, 64, 0, stream>>>(t2, t3, big, t1);
                        gemm_k<<<dim3(D / 64, S / 64), 256, 0, stream>>>(t1, DR, r_wo + (size_t)j * DR * D, D, hb, D, r_bo + (size_t)j * D, hb, D, DR, 0);
                    }
                } else {
                    rmsnorm_k<<<S, 256, 0, stream>>>(hb, norm_mlp + layer * D, hn);
                    gemm_k<<<dim3(FF / 64, S / 64), 256, 0, stream>>>(hn, D, w1 + (size_t)layer * D * FF, FF, big, FF, nullptr, nullptr, 0, D, 1);
                    gemm_k<<<dim3(D / 64, S / 64), 256, 0, stream>>>(big, FF, w2 + (size_t)layer * FF * D, D, hb, D, nullptr, hb, D, FF, 0);
                }
            }
        }
        for (int b = 0; b < B; ++b) { float* hb = h + (size_t)b * S * D; rmsnorm_k<<<S, 256, 0, stream>>>(hb, norm_final, hb); }
    }
#endif
}
```
